# Optimizing an MI355X kernel written in HIP

```python
import math
import jax
import jax.numpy as jnp
from jax import lax
import numpy as np

D_MODEL = 2048
BATCH = 4
SEQ = 4096
DEPTH = 2

CONV_CH = D_MODEL // 2
CONV_WIDTH = 31
MLSTM_HEADS = 8
MLSTM_HEAD_DIM = (D_MODEL // 2) // MLSTM_HEADS
MLSTM_WIDTH = MLSTM_HEADS * MLSTM_HEAD_DIM
MLSTM_QK_CONV = 4
MLSTM_CHUNK = 128
ATTN_HEADS = 8
ATTN_HEAD_DIM = (D_MODEL // 2) // ATTN_HEADS
ATTN_WIDTH = ATTN_HEADS * ATTN_HEAD_DIM
DILATED_BRANCHES = ((128, 1), (512, 4), (2048, 16))
ATTN_BLOCK = 128
SSM_CH = D_MODEL // 2
SSM_GROUP = 16
SSM_GROUPS = SSM_CH // SSM_GROUP
SSM_STATE = 64
DT_MIN = 1e-3
DT_MAX = 1e-1
D_FF = 5632
N_EXPERTS = 8
TOP_K = 2
RMS_EPS = 1e-6
LN_EPS = 1e-5
MIX0_WIDTH = CONV_CH + MLSTM_WIDTH
MIX1_WIDTH = ATTN_WIDTH + SSM_CH
IN0_COLS = 2 * CONV_CH + 4 * MLSTM_WIDTH + 2 * MLSTM_HEADS
IN1_COLS = 3 * ATTN_WIDTH + SSM_CH

kernel_name = 'hybrid_conv_mlstm_dilatedattn_s5_moe'


def rmsnorm(x, g):
    xf = x.astype(jnp.float32)
    y = xf * lax.rsqrt(jnp.mean(xf * xf, axis=-1, keepdims=True) + RMS_EPS)
    return (y * g.astype(jnp.float32)).astype(x.dtype)


def causal_depthwise_conv(x, w, b):
    k_len, ch = w.shape
    y = lax.conv_general_dilated(x, w[:, None, :].astype(x.dtype), window_strides=(1,),
                                 padding=[(k_len - 1, 0)],
                                 dimension_numbers=('NWC', 'WIO', 'NWC'),
                                 feature_group_count=ch)
    return y + b.astype(x.dtype)


def swiglu(x, w1, w3, w2):
    return (jax.nn.silu(x @ w1) * (x @ w3)) @ w2


def conformer_conv(u, conv_w, conv_b, ln_g, ln_b):
    val, gate = jnp.split(u, 2, axis=-1)
    a = causal_depthwise_conv(val * jax.nn.sigmoid(gate), conv_w, conv_b)
    af = a.astype(jnp.float32)
    mu = jnp.mean(af, axis=-1, keepdims=True)
    var = jnp.mean(jnp.square(af - mu), axis=-1, keepdims=True)
    an = (af - mu) * lax.rsqrt(var + LN_EPS) * ln_g.astype(jnp.float32) + ln_b.astype(jnp.float32)
    return jax.nn.silu(an).astype(u.dtype)


def mlstm_chunkwise(q, k, v, i_pre, f_pre):
    bsz, seq, nh, dh = q.shape
    L = MLSTM_CHUNK
    nc = seq // L
    f32 = jnp.float32

    def chunks(t):
        return t.astype(f32).reshape(bsz, nc, L, nh, -1).transpose(1, 0, 3, 2, 4)

    def gate_chunks(t):
        return t.astype(f32).reshape(bsz, nc, L, nh).transpose(1, 0, 3, 2)

    qc, kc, vc = chunks(q), chunks(k) * (dh ** -0.5), chunks(v)
    ic = gate_chunks(i_pre)
    bc = jnp.cumsum(jax.nn.log_sigmoid(gate_chunks(f_pre)), axis=-1)
    causal = jnp.tril(jnp.ones((L, L), dtype=bool))

    def step(carry, xs):
        c_mat, n_vec, m = carry
        q_, k_, v_, i_, b_ = xs
        log_d = jnp.where(causal, b_[..., :, None] - b_[..., None, :] + i_[..., None, :], -jnp.inf)
        inter = b_ + m[..., None]
        m_t = jnp.maximum(inter, jnp.max(log_d, axis=-1))
        s = jnp.einsum('bhtd,bhsd->bhts', q_, k_) * jnp.exp(log_d - m_t[..., None])
        w_int = jnp.exp(inter - m_t)
        num = jnp.einsum('bhts,bhsd->bhtd', s, v_) + w_int[..., None] * jnp.einsum('bhtd,bhde->bhte', q_, c_mat)
        den = jnp.sum(s, axis=-1) + w_int * jnp.einsum('bhtd,bhd->bht', q_, n_vec)
        h = num / jnp.maximum(jnp.abs(den), jnp.exp(-m_t))[..., None]
        b_last = b_[..., -1]
        g = b_last[..., None] - b_ + i_
        m_new = jnp.maximum(b_last + m, jnp.max(g, axis=-1))
        w_k = jnp.exp(g - m_new[..., None])
        decay = jnp.exp(b_last + m - m_new)
        c_mat = decay[..., None, None] * c_mat + jnp.einsum('bhs,bhsd,bhse->bhde', w_k, k_, v_)
        n_vec = decay[..., None] * n_vec + jnp.einsum('bhs,bhsd->bhd', w_k, k_)
        return (c_mat, n_vec, m_new), h

    init = (jnp.zeros((bsz, nh, dh, dh), f32), jnp.zeros((bsz, nh, dh), f32), jnp.zeros((bsz, nh), f32))
    _, h = lax.scan(step, init, (qc, kc, vc, ic, bc))
    return h.transpose(1, 0, 3, 2, 4).reshape(bsz, seq, nh, dh)


def dilated_branch(q, k, v, window, dil):
    bsz, seq, nh, dh = q.shape
    T = ATTN_BLOCK
    w_sub = window // dil
    ls = seq // dil
    nb = -(-ls // T)
    pad = nb * T - ls

    def sub(t):
        t = t.reshape(bsz, ls, dil, nh, dh).transpose(0, 2, 3, 1, 4)
        t = jnp.pad(t, ((0, 0), (0, 0), (0, 0), (0, pad), (0, 0)))
        return t.reshape(bsz, dil, nh, nb, T, dh)

    def band(t):
        prev = jnp.pad(t, ((0, 0), (0, 0), (0, 0), (1, 0), (0, 0), (0, 0)))[:, :, :, :nb]
        return jnp.concatenate([prev, t], axis=4)

    qb = sub(q)
    kk, vv = band(sub(k)), band(sub(v))
    s = jnp.einsum('brhnqd,brhnkd->brhnqk', qb, kk)
    qi = jnp.arange(T)[:, None]
    ki = jnp.arange(2 * T)[None, :]
    dist = T + qi - ki
    kpos = jnp.arange(nb)[:, None, None] * T - T + ki[None]
    valid = (dist >= 0) & (dist <= w_sub) & (kpos >= 0)
    s = jnp.where(valid, s, -jnp.inf)
    m = jnp.max(s, axis=-1, keepdims=True)
    p = jnp.exp(s - m)
    l = jnp.sum(p, axis=-1, keepdims=True)
    o = jnp.einsum('brhnqk,brhnkd->brhnqd', p, vv) / l
    lse = (m + jnp.log(l))[..., 0]
    o = o.reshape(bsz, dil, nh, nb * T, dh)[:, :, :, :ls].transpose(0, 3, 1, 2, 4).reshape(bsz, seq, nh, dh)
    lse = lse.reshape(bsz, dil, nh, nb * T)[:, :, :, :ls].transpose(0, 3, 1, 2).reshape(bsz, seq, nh)
    return o, lse


def dilated_attention(q, k, v):
    dh = q.shape[-1]
    qf = q.astype(jnp.float32) * (dh ** -0.5)
    kf, vf = k.astype(jnp.float32), v.astype(jnp.float32)
    results = [dilated_branch(qf, kf, vf, w, r) for (w, r) in DILATED_BRANCHES]
    outs = jnp.stack([o for (o, _) in results], axis=0)
    lses = jnp.stack([s for (_, s) in results], axis=0)
    alpha = jax.nn.softmax(lses, axis=0)
    return jnp.einsum('gbsh,gbshd->bshd', alpha, outs)


def _linear_recurrence_op(e1, e2):
    a1, b1 = e1
    a2, b2 = e2
    return a1 * a2, a2 * b1 + b2


def s5_layer(u, lam_re, lam_im, log_dt, b_re, b_im, c_re, c_im, d_skip, w_glu, b_glu):
    f32 = jnp.float32
    bsz, seq, _ = u.shape
    uf = u.astype(f32).reshape(bsz, seq, SSM_GROUPS, SSM_GROUP)
    lam = lax.complex(lam_re.astype(f32), lam_im.astype(f32))
    dt = jnp.exp(log_dt.astype(f32))[:, None]
    lam_bar = jnp.exp(lam * dt)
    b_mat = lax.complex(b_re.astype(f32), b_im.astype(f32))
    b_bar = ((lam_bar - 1.0) / lam)[..., None] * b_mat
    bu = jnp.einsum('bsgc,gpc->bsgp', uf.astype(jnp.complex64), b_bar)
    a = jnp.broadcast_to(lam_bar[None, None], (1, seq) + lam_bar.shape)
    _, state = lax.associative_scan(_linear_recurrence_op, (a, bu), axis=1)
    c_mat = lax.complex(c_re.astype(f32), c_im.astype(f32))
    y = jnp.einsum('bsgp,gcp->bsgc', state, c_mat).real + d_skip.astype(f32).reshape(SSM_GROUPS, SSM_GROUP) * uf
    y = jax.nn.gelu(y.reshape(bsz, seq, SSM_CH))
    y = y * jax.nn.sigmoid(y @ w_glu.astype(f32) + b_glu.astype(f32))
    return y.astype(u.dtype)


def moe_swiglu(x, router, w1, w3, w2):
    bsz, seq, d = x.shape
    xt = x.reshape(-1, d)
    logits = xt.astype(jnp.float32) @ router.astype(jnp.float32)
    top_v, top_i = lax.top_k(logits, TOP_K)
    gates = jax.nn.softmax(top_v, axis=-1)
    combine = jnp.einsum('tk,tke->te', gates, jax.nn.one_hot(top_i, N_EXPERTS, dtype=jnp.float32)).astype(x.dtype)
    y = jnp.zeros_like(xt)
    for e in range(N_EXPERTS):
        y = y + combine[:, e:e + 1] * swiglu(xt, w1[e], w3[e], w2[e])
    return y.reshape(bsz, seq, d)


def layer_conv_mlstm(x, norm_mix, w_in, conv_w, conv_b, ln_g, ln_b, qk_conv_w, qk_conv_b, b_i, b_f, w_out):
    bsz, seq, _ = x.shape
    z = rmsnorm(x, norm_mix) @ w_in
    cuts = [2 * CONV_CH, 2 * CONV_CH + 2 * MLSTM_WIDTH, 2 * CONV_CH + 3 * MLSTM_WIDTH,
            2 * CONV_CH + 4 * MLSTM_WIDTH, 2 * CONV_CH + 4 * MLSTM_WIDTH + MLSTM_HEADS]
    u_a, z_qk, z_v, z_o, z_i, z_f = jnp.split(z, cuts, axis=-1)
    out_a = conformer_conv(u_a, conv_w, conv_b, ln_g, ln_b)
    qk = jax.nn.silu(causal_depthwise_conv(z_qk, qk_conv_w, qk_conv_b))
    q, k = jnp.split(qk, 2, axis=-1)
    shp = (bsz, seq, MLSTM_HEADS, MLSTM_HEAD_DIM)
    i_pre = z_i.astype(jnp.float32) + b_i.astype(jnp.float32)
    f_pre = z_f.astype(jnp.float32) + b_f.astype(jnp.float32)
    h = mlstm_chunkwise(q.reshape(shp), k.reshape(shp), z_v.reshape(shp), i_pre, f_pre)
    out_b = (jax.nn.sigmoid(z_o.astype(jnp.float32)) * h.reshape(bsz, seq, MLSTM_WIDTH)).astype(x.dtype)
    return x + jnp.concatenate([out_a, out_b], axis=-1) @ w_out


def layer_attn_ssm(x, norm_mix, w_in, lam_re, lam_im, log_dt, b_re, b_im, c_re, c_im, d_skip, w_glu, b_glu, w_out):
    bsz, seq, _ = x.shape
    z = rmsnorm(x, norm_mix) @ w_in
    q, k, v, u = jnp.split(z, [ATTN_WIDTH, 2 * ATTN_WIDTH, 3 * ATTN_WIDTH], axis=-1)
    shp = (bsz, seq, ATTN_HEADS, ATTN_HEAD_DIM)
    out_c = dilated_attention(q.reshape(shp), k.reshape(shp), v.reshape(shp)).reshape(bsz, seq, ATTN_WIDTH).astype(x.dtype)
    out_d = s5_layer(u, lam_re, lam_im, log_dt, b_re, b_im, c_re, c_im, d_skip, w_glu, b_glu)
    return x + jnp.concatenate([out_c, out_d], axis=-1) @ w_out


def setup_inputs(seed: int = 0) -> dict:
    key = jax.random.key(seed)
    ks = iter(jax.random.split(key, 64))
    f32 = jnp.float32
    D = D_MODEL
    ne, no = (DEPTH + 1) // 2, DEPTH // 2
    G, P, H = SSM_GROUPS, SSM_STATE, MLSTM_HEADS

    def nrm(shape, scale):
        return jax.random.normal(next(ks), shape, f32) * scale

    def gain(shape):
        return 1.0 + nrm(shape, 0.02)

    inp = {}
    inp['x'] = nrm((BATCH, SEQ, D), 1.0)
    inp['e_norm_mix'] = gain((ne, D))
    inp['e_w_in'] = nrm((ne, D, IN0_COLS), D ** -0.5)
    inp['e_conv_w'] = nrm((ne, CONV_WIDTH, CONV_CH), CONV_WIDTH ** -0.5)
    inp['e_conv_b'] = nrm((ne, CONV_CH), 0.02)
    inp['e_ln_g'] = gain((ne, CONV_CH))
    inp['e_ln_b'] = nrm((ne, CONV_CH), 0.02)
    inp['e_qk_conv_w'] = nrm((ne, MLSTM_QK_CONV, 2 * MLSTM_WIDTH), MLSTM_QK_CONV ** -0.5)
    inp['e_qk_conv_b'] = nrm((ne, 2 * MLSTM_WIDTH), 0.02)
    inp['e_b_i'] = nrm((ne, H), 0.1)
    inp['e_b_f'] = jnp.linspace(3.0, 6.0, H, dtype=f32) + nrm((ne, H), 0.1)
    inp['e_w_out'] = nrm((ne, MIX0_WIDTH, D), MIX0_WIDTH ** -0.5)
    inp['e_norm_ffn'] = gain((ne, D))
    inp['e_ffn_w1'] = nrm((ne, D, D_FF), D ** -0.5)
    inp['e_ffn_w3'] = nrm((ne, D, D_FF), D ** -0.5)
    inp['e_ffn_w2'] = nrm((ne, D_FF, D), D_FF ** -0.5)
    inp['o_norm_mix'] = gain((no, D))
    inp['o_w_in'] = nrm((no, D, IN1_COLS), D ** -0.5)
    inp['o_lam_re'] = -0.5 + nrm((no, G, P), 0.01)
    inp['o_lam_im'] = math.pi * jnp.arange(P, dtype=f32) + nrm((no, G, P), 0.01)
    inp['o_log_dt'] = jax.random.uniform(next(ks), (no, G), f32, math.log(DT_MIN), math.log(DT_MAX))
    inp['o_b_re'] = nrm((no, G, P, SSM_GROUP), (2 * SSM_GROUP) ** -0.5)
    inp['o_b_im'] = nrm((no, G, P, SSM_GROUP), (2 * SSM_GROUP) ** -0.5)
    inp['o_c_re'] = nrm((no, G, SSM_GROUP, P), (2 * P) ** -0.5)
    inp['o_c_im'] = nrm((no, G, SSM_GROUP, P), (2 * P) ** -0.5)
    inp['o_d_skip'] = nrm((no, SSM_CH), 1.0)
    inp['o_w_glu'] = nrm((no, SSM_CH, SSM_CH), SSM_CH ** -0.5)
    inp['o_b_glu'] = nrm((no, SSM_CH), 0.02)
    inp['o_w_out'] = nrm((no, MIX1_WIDTH, D), MIX1_WIDTH ** -0.5)
    inp['o_norm_ffn'] = gain((no, D))
    inp['o_router'] = nrm((no, D, N_EXPERTS), D ** -0.5)
    inp['o_exp_w1'] = nrm((no, N_EXPERTS, D, D_FF), D ** -0.5)
    inp['o_exp_w3'] = nrm((no, N_EXPERTS, D, D_FF), D ** -0.5)
    inp['o_exp_w2'] = nrm((no, N_EXPERTS, D_FF, D), D_FF ** -0.5)
    inp['final_norm'] = gain((D,))
    return inp


def reference(x, e_norm_mix, e_w_in, e_conv_w, e_conv_b, e_ln_g, e_ln_b, e_qk_conv_w, e_qk_conv_b,
              e_b_i, e_b_f, e_w_out, e_norm_ffn, e_ffn_w1, e_ffn_w3, e_ffn_w2,
              o_norm_mix, o_w_in, o_lam_re, o_lam_im, o_log_dt, o_b_re, o_b_im, o_c_re, o_c_im,
              o_d_skip, o_w_glu, o_b_glu, o_w_out, o_norm_ffn, o_router, o_exp_w1, o_exp_w3, o_exp_w2,
              final_norm):
    for layer in range(DEPTH):
        j = layer // 2
        if layer % 2 == 0:
            x = layer_conv_mlstm(x, e_norm_mix[j], e_w_in[j], e_conv_w[j], e_conv_b[j], e_ln_g[j], e_ln_b[j],
                                 e_qk_conv_w[j], e_qk_conv_b[j], e_b_i[j], e_b_f[j], e_w_out[j])
            x = x + swiglu(rmsnorm(x, e_norm_ffn[j]), e_ffn_w1[j], e_ffn_w3[j], e_ffn_w2[j])
        else:
            x = layer_attn_ssm(x, o_norm_mix[j], o_w_in[j], o_lam_re[j], o_lam_im[j], o_log_dt[j],
                               o_b_re[j], o_b_im[j], o_c_re[j], o_c_im[j], o_d_skip[j], o_w_glu[j],
                               o_b_glu[j], o_w_out[j])
            x = x + moe_swiglu(rmsnorm(x, o_norm_ffn[j]), o_router[j], o_exp_w1[j], o_exp_w3[j], o_exp_w2[j])
    return rmsnorm(x, final_norm)
```

```cpp
#include <hip/hip_runtime.h>
#include <cstdio>
#include <cstdint>
namespace pg8 {
#define PG8_LAS __attribute__((address_space(3)))
typedef unsigned short bf16_t;
typedef short bf16x8 __attribute__((ext_vector_type(8)));
typedef float f32x4 __attribute__((ext_vector_type(4)));
typedef unsigned u32x4 __attribute__((ext_vector_type(4)));
constexpr int BM = 256, BK = 64, HALF = 128, HTB = HALF * BK * 2  , STAGE_BYTES = 8 * HTB, NXCD = 8, WGM = 4;

__host__ __device__ __forceinline__ int lds_byte(int r, int c) { const int st = (r >> 4) * 2 + (c >> 5), rr = r & 15, cc = c & 31, ob = rr * 64 + cc * 2; return st * 1024 + (ob ^ (((ob >> 9) & 1) << 5)); }
__host__ __device__ __forceinline__ void stage_rc(int b, int& R, int& C) { const int st = b / 1024, sb = b % 1024, swz = sb ^ (((sb >> 9) & 1) << 5); R = (st >> 1) * 16 + swz / 64; C = (st & 1) * 32 + (swz % 64) / 2; }
__host__ __device__ __forceinline__ int perm32(int rho) { const int n = rho >> 4, i = rho & 15; return 8 * (i >> 2) + 4 * n + (i & 3); }

struct Unit { int pm, pn; };
struct Gemm { const bf16_t* A; const bf16_t* Bt; int M, N, K; int sa, sb; };
typedef int i32x8 __attribute__((ext_vector_type(8)));
typedef int i32x4v __attribute__((ext_vector_type(4)));
__device__ __forceinline__ void mfma8(f32x4& acc, i32x8 a, i32x8 b, int sa_, int sb_) { asm volatile("v_mfma_scale_f32_16x16x128_f8f6f4 %0, %1, %2, %0, %3, %4 op_sel_hi:[0,0,0]" : "+v"(acc) : "v"(a), "v"(b), "v"(sa_), "v"(sb_)); }
__device__ __forceinline__ i32x8 cat8(bf16x8 a, bf16x8 b) { return __builtin_shufflevector(__builtin_bit_cast(i32x4v, a), __builtin_bit_cast(i32x4v, b), 0, 1, 2, 3, 4, 5, 6, 7); }

struct StaticOrder {
    int nM, nN, nwg, G, c;
    __host__ __device__ void init(int M, int N, int G_, int c_) { nM = M / BM; nN = N / BM; nwg = nM * nN; G = G_; c = c_; }
    __host__ __device__ bool next(int i, Unit& u) const {
        const long L = (long)i * G + c; if (L >= nwg) return false;
        int wgid = (int)L; { const int q = nwg / NXCD, r = nwg % NXCD, xcd = wgid % NXCD, off = wgid / NXCD; wgid = (xcd < r ? xcd * (q + 1) : r * (q + 1) + (xcd - r) * q) + off; }
        const int nig = WGM * nN, gid = wgid / nig, fm = gid * WGM, gsz = (nM - fm) < WGM ? (nM - fm) : WGM;
        u.pm = fm + ((wgid % nig) % gsz); u.pn = (wgid % nig) / gsz; return true;
    }
    __device__ __forceinline__ size_t bbase(const Unit&) const { return 0; }
    __device__ __forceinline__ void a_ready(const Unit&) const {}
    __device__ __forceinline__ void done(const Unit&) const {}
};
__device__ __forceinline__ unsigned cvt_pk_bf16(float lo, float hi) { unsigned r; asm volatile("v_cvt_pk_bf16_f32 %0, %1, %2" : "=v"(r) : "v"(lo), "v"(hi)); return r; }
__device__ __forceinline__ float sigm(float x) { return __builtin_amdgcn_rcpf(1.0f + __expf(-x)); }
typedef float f32x2p __attribute__((ext_vector_type(2)));
__device__ __forceinline__ f32x2p swiglu2(f32x2p a, f32x2p b, float inv_s) {
    const f32x2p t = a * (f32x2p){-1.4426950408889634f, -1.4426950408889634f};
    f32x2p e; e.x = __builtin_amdgcn_exp2f(t.x); e.y = __builtin_amdgcn_exp2f(t.y);
    const f32x2p d = e * (f32x2p){inv_s, inv_s} + (f32x2p){inv_s, inv_s};
    f32x2p r; r.x = __builtin_amdgcn_rcpf(d.x); r.y = __builtin_amdgcn_rcpf(d.y);
    return (a * b) * r;
}
__device__ __forceinline__ f32x2p glu2(f32x2p v, f32x2p g) {
    const f32x2p t = g * (f32x2p){-1.4426950408889634f, -1.4426950408889634f};
    f32x2p e; e.x = __builtin_amdgcn_exp2f(t.x); e.y = __builtin_amdgcn_exp2f(t.y);
    const f32x2p d = e + (f32x2p){1.0f, 1.0f};
    f32x2p r; r.x = __builtin_amdgcn_rcpf(d.x); r.y = __builtin_amdgcn_rcpf(d.y);
    return v * r;
}
__device__ __forceinline__ f32x4 glu4(const f32x4& v, const f32x4& g) {
    const f32x2p lo = glu2((f32x2p){v[0], v[1]}, (f32x2p){g[0], g[1]}), hi = glu2((f32x2p){v[2], v[3]}, (f32x2p){g[2], g[3]});
    return (f32x4){lo.x, lo.y, hi.x, hi.y};
}
__device__ __forceinline__ f32x4 swiglu4(const f32x4& a, const f32x4& b, float inv_s) {
    const f32x2p lo = swiglu2((f32x2p){a[0], a[1]}, (f32x2p){b[0], b[1]}, inv_s), hi = swiglu2((f32x2p){a[2], a[3]}, (f32x2p){b[2], b[3]}, inv_s);
    return (f32x4){lo.x, lo.y, hi.x, hi.y};
}
__device__ __forceinline__ u32x4 pack8(const f32x4& v0, const f32x4& v1) { u32x4 w; w.x = cvt_pk_bf16(v0[0], v0[1]); w.y = cvt_pk_bf16(v0[2], v0[3]); w.z = cvt_pk_bf16(v1[0], v1[1]); w.w = cvt_pk_bf16(v1[2], v1[3]); return w; }
__device__ __forceinline__ float bfl(unsigned w) { return __uint_as_float(w << 16); }
__device__ __forceinline__ float bfh(unsigned w) { return __uint_as_float(w & 0xffff0000u); }

struct EpiL0In {
    static constexpr bool PERM = true, AFTER_DRAIN = false;
    bf16_t* GLU; bf16_t* Z; int zoff;
    __device__ __forceinline__ void operator()(const f32x4 (&acc)[2][2][4][2], const Unit& u, int wr, int wc, int fr, int fq) const {
        const int row0 = u.pm * BM + wr * 64 + fr;
        if (u.pn < 8) {
            const int col0 = u.pn * 128 + wc * 32 + 8 * fq;
#pragma unroll
            for (int ai = 0; ai < 2; ++ai)
#pragma unroll
                for (int m = 0; m < 4; ++m) { bf16_t* rowp = GLU + (size_t)(row0 + ai * HALF + m * 16) * 1024 + col0; f32x4 v0, v1;
                    v0 = glu4(acc[ai][0][m][0], acc[ai][1][m][0]); v1 = glu4(acc[ai][0][m][1], acc[ai][1][m][1]);
                    *(u32x4*)rowp = pack8(v0, v1); }
        } else {
            const int col0 = zoff + (u.pn - 8) * BM + wc * 32 + 8 * fq;
#pragma unroll
            for (int ai = 0; ai < 2; ++ai)
#pragma unroll
                for (int m = 0; m < 4; ++m) { bf16_t* rowp = Z + (size_t)(row0 + ai * HALF + m * 16) * 4096 + col0;
#pragma unroll
                    for (int bj = 0; bj < 2; ++bj) *(u32x4*)(rowp + bj * HALF) = pack8(acc[ai][bj][m][0], acc[ai][bj][m][1]); }
        }
    }
};
struct EpiSwiglu {
    static constexpr bool PERM = true, AFTER_DRAIN = false;
    bf16_t* O; int ldc;
    __device__ __forceinline__ void operator()(const f32x4 (&acc)[2][2][4][2], const Unit& u, int wr, int wc, int fr, int fq) const {
        const int row0 = u.pm * BM + wr * 64 + fr, col0 = u.pn * 128 + wc * 32 + 8 * fq;
#pragma unroll
        for (int ai = 0; ai < 2; ++ai)
#pragma unroll
            for (int m = 0; m < 4; ++m) { bf16_t* rowp = O + (size_t)(row0 + ai * HALF + m * 16) * ldc + col0; f32x4 v0, v1;
                v0 = swiglu4(acc[ai][0][m][0], acc[ai][1][m][0], 1.0f); v1 = swiglu4(acc[ai][0][m][1], acc[ai][1][m][1], 1.0f);
                *(u32x4*)rowp = pack8(v0, v1); }
    }
};
__device__ __forceinline__ float clamp448(float x) { return __builtin_fminf(__builtin_fmaxf(x, -448.0f), 448.0f); }
__device__ __forceinline__ unsigned pk4_fp8(float a, float b, float c, float d) { unsigned w = 0u; w = __builtin_amdgcn_cvt_pk_fp8_f32(clamp448(a), clamp448(b), w, false); w = __builtin_amdgcn_cvt_pk_fp8_f32(clamp448(c), clamp448(d), w, true); return w; }
struct EpiSwiglu8 {
    static constexpr bool PERM = true, AFTER_DRAIN = false;
    unsigned char* O; int ldc;
    __device__ __forceinline__ void operator()(const f32x4 (&acc)[2][2][4][2], const Unit& u, int wr, int wc, int fr, int fq) const {
        const int row0 = u.pm * BM + wr * 64 + fr, col0 = u.pn * 128 + wc * 32 + 8 * fq;
#pragma unroll
        for (int ai = 0; ai < 2; ++ai)
#pragma unroll
            for (int m = 0; m < 4; ++m) { unsigned char* rowp = O + (size_t)(row0 + ai * HALF + m * 16) * ldc + col0; f32x4 v0, v1;
                v0 = swiglu4(acc[ai][0][m][0], acc[ai][1][m][0], 0.125f); v1 = swiglu4(acc[ai][0][m][1], acc[ai][1][m][1], 0.125f);
                typedef unsigned u32x2e __attribute__((ext_vector_type(2))); u32x2e w; w.x = pk4_fp8(v0[0], v0[1], v0[2], v0[3]); w.y = pk4_fp8(v1[0], v1[1], v1[2], v1[3]); *(u32x2e*)rowp = w; }
    }
};
struct EpiResid {
    static constexpr bool PERM = false, AFTER_DRAIN = false;
    const float* res; float* out; int ldc;
    __device__ __forceinline__ void operator()(const f32x4 (&acc)[2][2][4][2], const Unit& u, int wr, int wc, int fr, int fq) const {
        const int row0 = u.pm * BM + wr * 64 + fr, col0 = u.pn * BM + wc * 32 + 4 * fq;
#pragma unroll
        for (int ai = 0; ai < 2; ++ai) { f32x4 r[4][2][2];
#pragma unroll
            for (int m = 0; m < 4; ++m) { const size_t off = (size_t)(row0 + ai * HALF + m * 16) * ldc + col0;
#pragma unroll
                for (int bj = 0; bj < 2; ++bj)
#pragma unroll
                    for (int n = 0; n < 2; ++n) r[m][bj][n] = *(const f32x4*)(res + off + bj * HALF + n * 16); }
#pragma unroll
            for (int m = 0; m < 4; ++m) { const size_t off = (size_t)(row0 + ai * HALF + m * 16) * ldc + col0;
#pragma unroll
                for (int bj = 0; bj < 2; ++bj)
#pragma unroll
                    for (int n = 0; n < 2; ++n) *(f32x4*)(out + off + bj * HALF + n * 16) = r[m][bj][n] + acc[ai][bj][m][n]; } }
    }
};
struct EpiL1In {
    static constexpr bool PERM = true, AFTER_DRAIN = false;
    bf16_t* QKV; bf16_t* U;
    __device__ __forceinline__ void operator()(const f32x4 (&acc)[2][2][4][2], const Unit& u, int wr, int wc, int fr, int fq) const {
        const int row0 = u.pm * BM + wr * 64 + fr; const bool isu = u.pn >= 12;
        bf16_t* base = isu ? U : QKV; const int ldc = isu ? 1024 : 3072; const int col0 = (isu ? u.pn - 12 : u.pn) * BM + wc * 32 + 8 * fq;
        const float sc = u.pn < 4 ? 0.08838834764831845f : 1.0f;
#pragma unroll
        for (int ai = 0; ai < 2; ++ai)
#pragma unroll
            for (int m = 0; m < 4; ++m) { bf16_t* rowp = base + (size_t)(row0 + ai * HALF + m * 16) * ldc + col0;
#pragma unroll
                for (int bj = 0; bj < 2; ++bj) *(u32x4*)(rowp + bj * HALF) = pack8(acc[ai][bj][m][0] * sc, acc[ai][bj][m][1] * sc); }
    }
};
struct EpiGluGate {
    static constexpr bool PERM = true, AFTER_DRAIN = false;
    const bf16_t* Y; const float* bias; bf16_t* O; int ldo, ooff;
    __device__ __forceinline__ void operator()(const f32x4 (&acc)[2][2][4][2], const Unit& u, int wr, int wc, int fr, int fq) const {
        const int row0 = u.pm * BM + wr * 64 + fr, col0 = u.pn * BM + wc * 32 + 8 * fq;
        f32x4 bb[2][2];
#pragma unroll
        for (int bj = 0; bj < 2; ++bj) { bb[bj][0] = *(const f32x4*)(bias + col0 + bj * HALF); bb[bj][1] = *(const f32x4*)(bias + col0 + bj * HALF + 4); }
#pragma unroll
        for (int ai = 0; ai < 2; ++ai) { u32x4 yw[4][2];
#pragma unroll
            for (int m = 0; m < 4; ++m)
#pragma unroll
                for (int bj = 0; bj < 2; ++bj) yw[m][bj] = *(const u32x4*)(Y + (size_t)(row0 + ai * HALF + m * 16) * 1024 + col0 + bj * HALF);
#pragma unroll
            for (int m = 0; m < 4; ++m) { const size_t r = (size_t)(row0 + ai * HALF + m * 16);
#pragma unroll
                for (int bj = 0; bj < 2; ++bj) { const int c = col0 + bj * HALF; const u32x4 y = yw[m][bj];
                    const f32x4 a0 = acc[ai][bj][m][0] + bb[bj][0], a1 = acc[ai][bj][m][1] + bb[bj][1]; f32x4 v0, v1;
                    v0 = glu4((f32x4){bfl(y.x), bfh(y.x), bfl(y.y), bfh(y.y)}, a0); v1 = glu4((f32x4){bfl(y.z), bfh(y.z), bfl(y.w), bfh(y.w)}, a1);
                    *(u32x4*)(O + r * ldo + ooff + c) = pack8(v0, v1); } } }
    }
};
struct EpiPlain {
    static constexpr bool PERM = true, AFTER_DRAIN = false;
    bf16_t* O; int ldc;
    __device__ __forceinline__ void operator()(const f32x4 (&acc)[2][2][4][2], const Unit& u, int wr, int wc, int fr, int fq) const {
        const int row0 = u.pm * BM + wr * 64 + fr, col0 = u.pn * BM + wc * 32 + 8 * fq;
#pragma unroll
        for (int ai = 0; ai < 2; ++ai)
#pragma unroll
            for (int m = 0; m < 4; ++m) { bf16_t* rowp = O + (size_t)(row0 + ai * HALF + m * 16) * ldc + col0;
#pragma unroll
                for (int bj = 0; bj < 2; ++bj) *(u32x4*)(rowp + bj * HALF) = pack8(acc[ai][bj][m][0], acc[ai][bj][m][1]); }
    }
};
struct MoeOrder : StaticOrder {
    const int* tile_e; size_t estride;
    __device__ __forceinline__ size_t bbase(const Unit& u) const { return (size_t)tile_e[u.pm] * estride; }
};
template <class Epi, class Sched, bool ALIGN_EPI = false, bool SP2 = false, bool F8 = false>
__device__ __forceinline__ void gemm_phase(PG8_LAS unsigned char* lds, const Gemm g, const Sched& S, const Epi& E) {
    const int tid = threadIdx.x, wid = __builtin_amdgcn_readfirstlane(tid >> 6), lane = tid & 63, wr = wid >> 2, wc = wid & 3, fr = lane & 15, fq = lane >> 4;
    const int K = g.K, nt = K / BK;
    unsigned voffA[2], voffB[2];
#pragma unroll
    for (int i = 0; i < 2; ++i) { int R, C; stage_rc(tid * 16 + i * 8192, R, C); const int Rb = Epi::PERM ? ((R & ~31) + perm32(R & 31)) : R;
        voffA[i] = (unsigned)(R * K + C) * 2u; voffB[i] = (unsigned)(tid * 16 + i * 8192); (void)Rb; }
    const size_t kstep = (size_t)(BK * 2);
    const size_t hstep = (size_t)HALF * K * 2;
    const size_t tstep = 2 * hstep;
    const size_t kstepB = (size_t)2 * HTB, hstepB = (size_t)HTB, tstepB = (size_t)nt * 2 * HTB;
    const unsigned ldsw = (unsigned)wid * 1024u;
    const int aoff = lds_byte(wr * 64 + fr, fq * 8), boff = lds_byte(wc * 32 + fr, fq * 8);
#define PG8_SA(b, h) (((b) * 2 + (h)) * HTB)
#define PG8_SB(b, h) ((4 + (b) * 2 + (h)) * HTB)
#define PG8_STAGE(bufoff, gbase, voff) do { _Pragma("unroll") for (int _i = 0; _i < 2; ++_i) \
        __builtin_amdgcn_global_load_lds((const unsigned*)((const char*)(gbase) + (voff)[_i]), (PG8_LAS unsigned*)(lds + (bufoff) + ldsw + _i * 8192), 16, 0, 0); } while (0)
#define PG8_LDA(dst, b, h) do { _Pragma("unroll") for (int m = 0; m < 4; ++m) _Pragma("unroll") for (int k = 0; k < 2; ++k) dst[m][k] = *(const PG8_LAS bf16x8*)(lds + PG8_SA(b, h) + aoff + m * 2048 + k * 1024); } while (0)
#define PG8_LDB(dst, b, h) do { _Pragma("unroll") for (int n = 0; n < 2; ++n) _Pragma("unroll") for (int k = 0; k < 2; ++k) dst[n][k] = *(const PG8_LAS bf16x8*)(lds + PG8_SB(b, h) + boff + n * 2048 + k * 1024); } while (0)
#define PG8_MMA(ai, bj, At, Bt) do { __builtin_amdgcn_s_setprio(1); if constexpr (F8) { _Pragma("unroll") for (int m = 0; m < 4; ++m) _Pragma("unroll") for (int n = 0; n < 2; ++n) \
        mfma8(acc[ai][bj][m][n], cat8(Bt[n][0], Bt[n][1]), cat8(At[m][0], At[m][1]), g.sb, g.sa); } else { \
        _Pragma("unroll") for (int m = 0; m < 4; ++m) _Pragma("unroll") for (int n = 0; n < 2; ++n) _Pragma("unroll") for (int k = 0; k < 2; ++k) \
        acc[ai][bj][m][n] = __builtin_amdgcn_mfma_f32_16x16x32_bf16(Bt[n][k], At[m][k], acc[ai][bj][m][n], 0, 0, 0); } __builtin_amdgcn_s_setprio(0); } while (0)
#define PG8_WAIT_V(n) asm volatile("s_waitcnt vmcnt(" #n ")" ::: "memory")
#define PG8_WAIT_L(n) asm volatile("s_waitcnt lgkmcnt(" #n ")" ::: "memory")
#define PG8_BAR __builtin_amdgcn_s_barrier()
#define PG8_SCHED __builtin_amdgcn_sched_barrier(0)
    Unit cur, nxt; int ui = 0;
    if (!S.next(0, cur)) return;
    f32x4 acc[2][2][4][2];
#pragma unroll
    for (int a = 0; a < 2; ++a)
#pragma unroll
        for (int b = 0; b < 2; ++b)
#pragma unroll
            for (int m = 0; m < 4; ++m)
#pragma unroll
                for (int n = 0; n < 2; ++n) acc[a][b][m][n] = (f32x4){0.f, 0.f, 0.f, 0.f};
    bf16x8 At[4][2], B0[2][2], B1[2][2];
    const char* cA = (const char*)g.A + (size_t)cur.pm * tstep; const char* cB = (const char*)g.Bt + S.bbase(cur) + (size_t)cur.pn * tstepB;
    S.a_ready(cur);
    if constexpr (SP2) {
        PG8_STAGE(PG8_SB(0, 0), cB, voffB); PG8_STAGE(PG8_SB(0, 1), cB + hstepB, voffB); PG8_STAGE(PG8_SA(0, 0), cA, voffA); PG8_STAGE(PG8_SA(0, 1), cA + hstep, voffA);
        if (wr == 1) PG8_BAR;
        PG8_WAIT_V(2); PG8_BAR;
        PG8_STAGE(PG8_SB(1, 0), cB + kstepB, voffB); PG8_STAGE(PG8_SB(1, 1), cB + hstepB + kstepB, voffB);
        PG8_WAIT_V(4); PG8_BAR;
    } else {
        PG8_STAGE(PG8_SB(0, 0), cB, voffB); PG8_STAGE(PG8_SA(0, 0), cA, voffA); PG8_STAGE(PG8_SB(0, 1), cB + hstepB, voffB); PG8_STAGE(PG8_SA(0, 1), cA + hstep, voffA);
        if (wr == 1) PG8_BAR;
        PG8_WAIT_V(4); PG8_BAR;
        PG8_STAGE(PG8_SB(1, 0), cB + kstepB, voffB); PG8_STAGE(PG8_SA(1, 0), cA + kstep, voffA); PG8_STAGE(PG8_SB(1, 1), cB + hstepB + kstepB, voffB);
        PG8_WAIT_V(6); PG8_BAR;
    }
    for (;;) {
        const bool has_next = S.next(ui + 1, nxt);
        const char* nA = has_next ? (const char*)g.A + (size_t)nxt.pm * tstep : cA; const char* nB = has_next ? (const char*)g.Bt + S.bbase(nxt) + (size_t)nxt.pn * tstepB : cB;
        for (int t = 0; t < nt; t += 2) {
            const bool last = (t == nt - 2);
            const char* a1 = cA + (size_t)(t + 1) * kstep;
            const char* a2 = last ? nA : cA + (size_t)(t + 2) * kstep; const char* b2 = last ? nB : cB + (size_t)(t + 2) * kstepB;
            const char* a3 = a2 + kstep; const char* b3 = b2 + kstepB;
            if (last && has_next) S.a_ready(nxt);
            if constexpr (SP2) {
            PG8_LDB(B0, 0, 0); PG8_LDB(B1, 0, 1); PG8_SCHED; PG8_LDA(At, 0, 0); PG8_STAGE(PG8_SA(1, 0), a1, voffA); PG8_STAGE(PG8_SA(1, 1), a1 + hstep, voffA);
            PG8_WAIT_V(8); PG8_WAIT_L(0); PG8_BAR; PG8_MMA(0, 0, At, B0); PG8_MMA(0, 1, At, B1); PG8_BAR; PG8_SCHED;
            PG8_LDA(At, 0, 1); PG8_STAGE(PG8_SB(0, 0), b2, voffB); PG8_STAGE(PG8_SB(0, 1), b2 + hstepB, voffB);
            PG8_WAIT_V(6); PG8_WAIT_L(0); PG8_BAR; PG8_MMA(1, 0, At, B0); PG8_MMA(1, 1, At, B1); PG8_BAR; PG8_SCHED;
            PG8_LDB(B0, 1, 0); PG8_LDB(B1, 1, 1); PG8_SCHED; PG8_LDA(At, 1, 0); PG8_STAGE(PG8_SA(0, 0), a2, voffA); PG8_STAGE(PG8_SA(0, 1), a2 + hstep, voffA);
            PG8_WAIT_V(8); PG8_WAIT_L(0); PG8_BAR; PG8_MMA(0, 0, At, B0); PG8_MMA(0, 1, At, B1); PG8_BAR; PG8_SCHED;
            PG8_LDA(At, 1, 1); PG8_STAGE(PG8_SB(1, 0), b3, voffB); PG8_STAGE(PG8_SB(1, 1), b3 + hstepB, voffB);
            PG8_WAIT_V(6); PG8_WAIT_L(0); PG8_BAR; PG8_MMA(1, 0, At, B0); PG8_MMA(1, 1, At, B1); PG8_BAR; PG8_SCHED;
            (void)a3;
            } else {
            PG8_LDB(B0, 0, 0); PG8_SCHED; PG8_LDA(At, 0, 0); PG8_STAGE(PG8_SA(1, 1), a1 + hstep, voffA);
            PG8_WAIT_L(8); PG8_BAR; PG8_WAIT_L(0); PG8_MMA(0, 0, At, B0); PG8_BAR; PG8_SCHED;
            PG8_LDB(B1, 0, 1); PG8_STAGE(PG8_SB(0, 0), b2, voffB);
            PG8_BAR; PG8_WAIT_L(0); PG8_MMA(0, 1, At, B1); PG8_BAR;
            PG8_LDA(At, 0, 1); PG8_STAGE(PG8_SA(0, 0), a2, voffA);
            PG8_BAR; PG8_WAIT_L(0); PG8_MMA(1, 0, At, B0); PG8_BAR; PG8_SCHED;
            PG8_STAGE(PG8_SB(0, 1), b2 + hstepB, voffB);
            PG8_WAIT_V(6); PG8_BAR; PG8_MMA(1, 1, At, B1); PG8_BAR;
            PG8_LDB(B0, 1, 0); PG8_SCHED; PG8_LDA(At, 1, 0); PG8_STAGE(PG8_SA(0, 1), a2 + hstep, voffA);
            PG8_WAIT_L(8); PG8_BAR; PG8_WAIT_L(0); PG8_MMA(0, 0, At, B0); PG8_BAR; PG8_SCHED;
            PG8_LDB(B1, 1, 1); PG8_STAGE(PG8_SB(1, 0), b3, voffB);
            PG8_BAR; PG8_WAIT_L(0); PG8_MMA(0, 1, At, B1); PG8_BAR;
            PG8_LDA(At, 1, 1); PG8_STAGE(PG8_SA(1, 0), a3, voffA);
            PG8_BAR; PG8_WAIT_L(0); PG8_MMA(1, 0, At, B0); PG8_BAR; PG8_SCHED;
            PG8_STAGE(PG8_SB(1, 1), b3 + hstepB, voffB);
            PG8_WAIT_V(6); PG8_BAR; PG8_MMA(1, 1, At, B1); PG8_BAR;
            }
        }
        if constexpr (ALIGN_EPI) { if (wr == 0) PG8_BAR; }
        if constexpr (F8) { asm volatile("s_nop 15\n\ts_nop 15" ::: "memory"); }
        if constexpr (!Epi::AFTER_DRAIN) { E(acc, cur, wr, wc, fr, fq); S.done(cur); }
        if (!has_next) break;
#pragma unroll
        for (int a = 0; a < 2; ++a)
#pragma unroll
            for (int b = 0; b < 2; ++b)
#pragma unroll
                for (int m = 0; m < 4; ++m)
#pragma unroll
                    for (int n = 0; n < 2; ++n) acc[a][b][m][n] = (f32x4){0.f, 0.f, 0.f, 0.f};
        cur = nxt; cA = nA; cB = nB; ++ui;
        if constexpr (ALIGN_EPI) { if (wr == 1) PG8_BAR; }
    }
    PG8_WAIT_V(0);
    if constexpr (!ALIGN_EPI) { if (wr == 0) PG8_BAR; }
    PG8_BAR;
    if constexpr (Epi::AFTER_DRAIN) { E.fused(acc, cur, wr, wc, fr, fq, lds, wid, lane); S.done(cur); }
#undef PG8_SA
#undef PG8_SB
#undef PG8_STAGE
#undef PG8_LDA
#undef PG8_LDB
#undef PG8_MMA
#undef PG8_WAIT_V
#undef PG8_WAIT_L
#undef PG8_BAR
#undef PG8_SCHED
}
}
#define DI __device__ __forceinline__
#define LAS __attribute__((address_space(3)))
typedef unsigned short bf16;
typedef short bf16x8 __attribute__((ext_vector_type(8)));
typedef short s16x4 __attribute__((ext_vector_type(4)));
typedef float f32x4 __attribute__((ext_vector_type(4)));
typedef float f32x2 __attribute__((ext_vector_type(2)));
typedef float f32x16 __attribute__((ext_vector_type(16)));
typedef unsigned u32x4 __attribute__((ext_vector_type(4)));
typedef unsigned u32x2 __attribute__((ext_vector_type(2)));

constexpr int M = 16384, D = 2048, SEQ = 4096, NH = 8, DH = 128, FF = 5632, NE = 8;
constexpr int NWAVES = 8, NTHR = 512;
constexpr float RMS_EPS = 1e-6f, LN_EPS = 1e-5f;

enum { I_X = 0, I_E_NORM_MIX, I_E_W_IN, I_E_CONV_W, I_E_CONV_B, I_E_LN_G, I_E_LN_B, I_E_QKCONV_W, I_E_QKCONV_B, I_E_B_I, I_E_B_F, I_E_W_OUT, I_E_NORM_FFN, I_E_W1, I_E_W3, I_E_W2,
       I_O_NORM_MIX, I_O_W_IN, I_O_LAM_RE, I_O_LAM_IM, I_O_LOG_DT, I_O_B_RE, I_O_B_IM, I_O_C_RE, I_O_C_IM, I_O_D_SKIP, I_O_W_GLU, I_O_B_GLU, I_O_W_OUT, I_O_NORM_FFN, I_O_ROUTER,
       I_O_EW1, I_O_EW3, I_O_EW2, I_FINAL_NORM, N_IN };

constexpr size_t MiB = 1u << 20, KiB = 1u << 10;
constexpr size_t WS_CTL = 0, CTL_BYTES = 1 * MiB;
constexpr size_t WS_GATES = 1 * MiB;
constexpr size_t WS_BCUM = 2 * MiB;
constexpr size_t WS_AVAL = 2 * MiB + 512 * KiB;
constexpr size_t WS_BLAST = 4 * MiB + 128 * KiB, WS_AMAX = WS_BLAST + 4, WS_MPREV = 3 * MiB;
constexpr size_t WS_NLOC = 3 * MiB + 64 * KiB, WS_NPREV = WS_NLOC + 512 * KiB;
constexpr size_t WS_MXL = 4 * MiB + 512 * KiB;
constexpr size_t WS_TOKE = 7 * MiB + 512 * KiB, WS_TOKG = WS_TOKE + 128 * KiB, WS_SLOT = WS_TOKG + 128 * KiB;
constexpr size_t WS_CNT = WS_SLOT + 128 * KiB;
constexpr size_t WS_TILEE = WS_CNT + 32 * KiB;
constexpr size_t WS_W0IN = 8 * MiB, WS_W0OUT = 32 * MiB, WS_W013 = 40 * MiB, WS_W02 = 84 * MiB, WS_W1IN = 106 * MiB, WS_WGLU = 122 * MiB, WS_W1OUT = 124 * MiB, WS_WE13 = 132 * MiB, WS_WE2 = 484 * MiB;
constexpr size_t A0 = 660 * MiB;
constexpr size_t WS_XN = A0, WS_MIX = A0 + 64 * MiB, R0 = A0 + 128 * MiB;
constexpr size_t WS_GLU = R0, WS_Z = R0 + 32 * MiB, WS_QC = R0 + 160 * MiB, WS_KC = R0 + 192 * MiB, WS_CLOC = R0 + 224 * MiB, WS_CPREV = R0 + 288 * MiB;
constexpr size_t WS_H = R0;
constexpr size_t WS_QKV = R0, WS_U = R0 + 96 * MiB, WS_OG = R0 + 128 * MiB, WS_Y = R0 + 224 * MiB;
constexpr size_t WS_HG = A0, WS_XG = A0 + 374 * MiB;
constexpr size_t WS_END = A0 + 510 * MiB;
constexpr int MAXTILES = 136;
constexpr int CW_BAR = 4096;

constexpr int LDS_BYTES = 147456, MISC_OFF = LDS_BYTES - 256;

struct Params { const float* in[N_IN]; float* out; unsigned char* ws; int lo, hi; };

struct Ctx { LAS unsigned char* lds; int tid, lane, wave, bid, nb; };

DI float wave_sum(float v) {
#pragma unroll
    for (int o = 1; o < 64; o <<= 1) v += __shfl_xor(v, o);
    return v;
}
DI float wave_max(float v) {
#pragma unroll
    for (int o = 1; o < 64; o <<= 1) v = fmaxf(v, __shfl_xor(v, o));
    return v;
}
DI unsigned pk2(float lo, float hi) { unsigned r; asm("v_cvt_pk_bf16_f32 %0, %1, %2" : "=v"(r) : "v"(lo), "v"(hi)); return r; }
typedef __bf16 bf16x2_t __attribute__((ext_vector_type(2)));
DI unsigned pk2m(float lo, float hi) { f32x2 v = {lo, hi}; return __builtin_bit_cast(unsigned, __builtin_convertvector(v, bf16x2_t)); }
DI float bfl(unsigned w) { return __uint_as_float(w << 16); }
DI float bfh(unsigned w) { return __uint_as_float(w & 0xffff0000u); }
DI float bf1(bf16 b) { return __uint_as_float(((unsigned)b) << 16); }
DI float sigm(float x) { return __builtin_amdgcn_rcpf(1.0f + __expf(-x)); }
DI float silu(float x) { return x * sigm(x); }
#define LDS_WAIT() asm volatile("s_waitcnt lgkmcnt(0)" ::: "memory")
#define MFMA16(a, b, c) __builtin_amdgcn_mfma_f32_16x16x32_bf16((a), (b), (c), 0, 0, 0)
#define MFMA32(a, b, c) __builtin_amdgcn_mfma_f32_32x32x16_bf16((a), (b), (c), 0, 0, 0)

DI int toff(int row, int ch) { return 256 * row + 16 * (ch ^ (((row & 3) << 2) | ((row >> 2) & 3))); }
DI bf16x8 ldrow(LAS unsigned char* tile, int row, int ch) { return *(const LAS bf16x8*)(tile + toff(row, ch)); }
DI s16x4 ldtr(LAS unsigned char* tile, int R0, int c16, int lane) {
    const int q = (lane & 15) >> 2, p = lane & 3;
    return __builtin_bit_cast(s16x4, __builtin_amdgcn_ds_read_tr16_b64_v4i16((LAS s16x4*)(tile + toff(R0 + q, 2 * c16 + (p >> 1)) + 8 * (p & 1))));
}
DI bf16x8 cat4(s16x4 a, s16x4 b) { bf16x8 r; r[0] = a[0]; r[1] = a[1]; r[2] = a[2]; r[3] = a[3]; r[4] = b[0]; r[5] = b[1]; r[6] = b[2]; r[7] = b[3]; return r; }
DI bf16x8 pack8f(const f32x4& a, const f32x4& b) { u32x4 w; w.x = pk2m(a[0], a[1]); w.y = pk2m(a[2], a[3]); w.z = pk2m(b[0], b[1]); w.w = pk2m(b[2], b[3]); return __builtin_bit_cast(bf16x8, w); }

DI float clamp448(float x) { return fminf(fmaxf(x, -448.0f), 448.0f); }
DI unsigned pk4_fp8(float a, float b, float c, float d) { unsigned w = 0u; w = __builtin_amdgcn_cvt_pk_fp8_f32(clamp448(a), clamp448(b), w, false); w = __builtin_amdgcn_cvt_pk_fp8_f32(clamp448(c), clamp448(d), w, true); return w; }
struct CvItem { const float* W; unsigned char* WT; int ldw, K, k0, n0, drow; bool f8, perm; };
DI size_t bt_off(int nrow, int kc, int ntiles_k, bool perm) {
    const int pn = nrow >> 8, h = (nrow >> 7) & 1, rp = nrow & 127, t = kc >> 6, cc = kc & 63;
    const int p = rp & 31, slot = perm ? ((rp & ~31) + 16 * ((p >> 2) & 1) + 4 * (p >> 3) + (p & 3)) : rp;
    return ((size_t)pn * ntiles_k + t) * (2 * pg8::HTB) + (size_t)h * pg8::HTB + pg8::lds_byte(slot, cc);
}
DI void cv_load(const CvItem& it, int half, int lane, f32x4 (&r)[16]) {
    const int kq = lane >> 4, c4 = (lane & 15) * 4; const float* src = it.W + (size_t)(it.k0 + 64 * half + kq) * it.ldw + it.n0 + c4;
#pragma unroll
    for (int i = 0; i < 16; ++i) r[i] = __builtin_nontemporal_load((const f32x4*)(src + (size_t)(4 * i) * it.ldw));
}
DI void cv_to_lds(const f32x4 (&r)[16], LAS float* scr, int lane) {
    const int kq = lane >> 4, c4 = (lane & 15) * 4;
#pragma unroll
    for (int i = 0; i < 16; ++i) { LAS float* s = scr + (kq + 4 * i) * 65 + c4; s[0] = r[i].x; s[1] = r[i].y; s[2] = r[i].z; s[3] = r[i].w; }
    LDS_WAIT();
}
DI void cv_out_bf16(const CvItem& it, int half, LAS float* scr, int lane) {
    const int c = lane & 7;
#pragma unroll
    for (int j = 0; j < 8; ++j) { const int n = (lane >> 3) + 8 * j; const LAS float* s = scr + (8 * c) * 65 + n;
        u32x4 o; o.x = pk2(s[0 * 65], s[1 * 65]); o.y = pk2(s[2 * 65], s[3 * 65]); o.z = pk2(s[4 * 65], s[5 * 65]); o.w = pk2(s[6 * 65], s[7 * 65]);
        *(u32x4*)(it.WT + bt_off(it.drow + n, it.k0 + 64 * half + 8 * c, it.K / 64, it.perm)) = o; }
    LDS_WAIT();
}
DI void cv_out_f8(const CvItem& it, int half, LAS float* scr, int lane) {
    const int c = lane & 3;
#pragma unroll
    for (int j = 0; j < 4; ++j) { const int n = (lane >> 2) + 16 * j; const LAS float* s = scr + (16 * c) * 65 + n; u32x4 o;
        o.x = pk4_fp8(64.f * s[0 * 65], 64.f * s[1 * 65], 64.f * s[2 * 65], 64.f * s[3 * 65]); o.y = pk4_fp8(64.f * s[4 * 65], 64.f * s[5 * 65], 64.f * s[6 * 65], 64.f * s[7 * 65]);
        o.z = pk4_fp8(64.f * s[8 * 65], 64.f * s[9 * 65], 64.f * s[10 * 65], 64.f * s[11 * 65]); o.w = pk4_fp8(64.f * s[12 * 65], 64.f * s[13 * 65], 64.f * s[14 * 65], 64.f * s[15 * 65]);
        *(u32x4*)(it.WT + bt_off(it.drow + n, (it.k0 + 64 * half + 16 * c) >> 1, it.K / 128, it.perm)) = o; }
    LDS_WAIT();
}
DI int cv_drow(int mode, int n0) {
    if (mode == 0) return n0;
    if (mode == 1) return 256 * (n0 >> 7) + (n0 & 127);
    if (mode == 2) return 256 * (n0 >> 7) + 128 + (n0 & 127);
    if (n0 < 1024) return 256 * (n0 >> 7) + (n0 & 127);
    if (n0 < 2048) { const int n1 = n0 - 1024; return 256 * (n1 >> 7) + 128 + (n1 & 127); }
    return n0;
}
DI void cv_mat(CvItem& o, const float* W, int ldw, int K, int N, unsigned char* WT, int mode, bool f8, int it, bool perm) {
    o.perm = perm;
    const int nblk = N / 64, kb = it / nblk, nb_ = it % nblk; o.W = W; o.WT = WT; o.ldw = ldw; o.K = K; o.k0 = kb * 128; o.n0 = nb_ * 64; o.drow = cv_drow(mode, o.n0); o.f8 = f8;
}
constexpr int CI_IN0A = (D / 128) * (2048 / 64), CI_IN0C = (D / 128) * (4096 / 64), CI_IN0 = CI_IN0A + CI_IN0C, CI_SQ = (D / 128) * (D / 64), CI_UP = (D / 128) * (FF / 64), CI_DN = (FF / 128) * (D / 64), CI_IN1Q = (D / 128) * (3072 / 64), CI_IN1U = (D / 128) * (1024 / 64), CI_IN1 = CI_IN1Q + CI_IN1U, CI_GLU = 8 * 16;
constexpr int CV_NIT = CI_IN0 + CI_SQ + 2 * CI_UP + CI_DN + CI_IN1 + CI_GLU + CI_SQ + NE * (2 * CI_UP + CI_DN);
DI void cv_locate(const Params& p, int it, CvItem& o) {
    unsigned char* ws = p.ws; int r = it;
    if (r < CI_IN0A) { cv_mat(o, p.in[I_E_W_IN], 6160, D, 2048, ws + WS_W0IN, 3, false, r, true); return; } r -= CI_IN0A;
    if (r < CI_IN0C) { cv_mat(o, p.in[I_E_W_IN] + 2048, 6160, D, 4096, ws + WS_W0IN + 12 * MiB, 0, true, r, true); return; } r -= CI_IN0C;
    if (r < CI_SQ) { cv_mat(o, p.in[I_E_W_OUT], D, D, D, ws + WS_W0OUT, 0, false, r, false); return; } r -= CI_SQ;
    if (r < CI_UP) { cv_mat(o, p.in[I_E_W1], FF, D, FF, ws + WS_W013, 1, false, r, true); return; } r -= CI_UP;
    if (r < CI_UP) { cv_mat(o, p.in[I_E_W3], FF, D, FF, ws + WS_W013, 2, false, r, true); return; } r -= CI_UP;
    if (r < CI_DN) { cv_mat(o, p.in[I_E_W2], D, FF, D, ws + WS_W02, 0, false, r, false); return; } r -= CI_DN;
    if (r < CI_IN1) { cv_mat(o, p.in[I_O_W_IN], 4096, D, 4096, ws + WS_W1IN, 0, true, r, true); return; } r -= CI_IN1;
    if (r < CI_GLU) { cv_mat(o, p.in[I_O_W_GLU], 1024, 1024, 1024, ws + WS_WGLU, 0, false, r, true); return; } r -= CI_GLU;
    if (r < CI_SQ) { cv_mat(o, p.in[I_O_W_OUT], D, D, D, ws + WS_W1OUT, 0, false, r, false); return; } r -= CI_SQ;
    const int per_e = 2 * CI_UP + CI_DN, e = r / per_e; r -= e * per_e;
    if (r < CI_UP) { cv_mat(o, p.in[I_O_EW1] + (size_t)e * D * FF, FF, D, FF, ws + WS_WE13 + (size_t)e * 2 * FF * D, 1, true, r, true); return; } r -= CI_UP;
    if (r < CI_UP) { cv_mat(o, p.in[I_O_EW3] + (size_t)e * D * FF, FF, D, FF, ws + WS_WE13 + (size_t)e * 2 * FF * D, 2, true, r, true); return; } r -= CI_UP;
    cv_mat(o, p.in[I_O_EW2] + (size_t)e * FF * D, D, FF, D, ws + WS_WE2 + (size_t)e * D * FF, 0, true, r, true);
}
DI void phase_convert(const Params& p, const Ctx& c) {
    LAS float* scr = (LAS float*)(c.lds + c.wave * 16640);
    const int gw = c.bid * NWAVES + c.wave, NGW = c.nb * NWAVES;
    if (gw >= CV_NIT) return;
    CvItem cur, nxt; f32x4 ra[16], rb[16];
    cv_locate(p, gw, cur); cv_load(cur, 0, c.lane, ra);
    for (int it = gw; it < CV_NIT; it += NGW) {
        const bool has_next = it + NGW < CV_NIT;
        cv_load(cur, 1, c.lane, rb);
        cv_to_lds(ra, scr, c.lane);
        if (cur.f8) cv_out_f8(cur, 0, scr, c.lane); else cv_out_bf16(cur, 0, scr, c.lane);
        if (has_next) { cv_locate(p, it + NGW, nxt); cv_load(nxt, 0, c.lane, ra); }
        cv_to_lds(rb, scr, c.lane);
        if (cur.f8) cv_out_f8(cur, 1, scr, c.lane); else cv_out_bf16(cur, 1, scr, c.lane);
        cur = nxt;
    }
}

DI void rms_ldg(const float* g, int lane, f32x4 (&gg)[8]) {
#pragma unroll
    for (int j = 0; j < 8; ++j) gg[j] = *(const f32x4*)(g + 4 * lane + 256 * j);
}
template <bool F8 = false> DI void rms_row(const float* xrow, const f32x4 (&gg)[8], void* orow_, int lane, f32x4 (&v)[8]) {
    bf16* orow = (bf16*)orow_;
    float s = 0.f;
#pragma unroll
    for (int j = 0; j < 8; ++j) { v[j] = *(const f32x4*)(xrow + 4 * lane + 256 * j); s += (v[j].x * v[j].x + v[j].y * v[j].y) + (v[j].z * v[j].z + v[j].w * v[j].w); }
    const float rstd = rsqrtf(wave_sum(s) * (1.0f / D) + RMS_EPS);
#pragma unroll
    for (int j = 0; j < 8; ++j) { v[j] = v[j] * rstd * gg[j];
        if constexpr (F8) { *(unsigned*)((unsigned char*)orow_ + 4 * lane + 256 * j) = pk4_fp8(v[j].x, v[j].y, v[j].z, v[j].w); }
        else { u32x2 w; w.x = pk2(v[j].x, v[j].y); w.y = pk2(v[j].z, v[j].w); *(u32x2*)(orow + 4 * lane + 256 * j) = w; } }
}
DI void phase_rms2(const float* X, const float* g, bf16* XNb, unsigned char* XN8, const Ctx& c) {
    const int gw = c.bid * NWAVES + c.wave, NGW = c.nb * NWAVES;
    f32x4 gg[8]; rms_ldg(g, c.lane, gg);
    for (int m = gw; m < M; m += NGW) { f32x4 v[8]; rms_row<false>(X + (size_t)m * D, gg, XNb + (size_t)m * D, c.lane, v);
#pragma unroll
        for (int j = 0; j < 8; ++j) *(unsigned*)(XN8 + (size_t)m * D + 4 * c.lane + 256 * j) = pk4_fp8(v[j].x, v[j].y, v[j].z, v[j].w); }
}
template <bool F8> DI void phase_rms(const float* X, const float* g, void* XN, const Ctx& c) {
    const int gw = c.bid * NWAVES + c.wave, NGW = c.nb * NWAVES;
    f32x4 gg[8]; rms_ldg(g, c.lane, gg);
    f32x4 vn[8];
    if (gw < M) {
#pragma unroll
        for (int j = 0; j < 8; ++j) vn[j] = *(const f32x4*)(X + (size_t)gw * D + 4 * c.lane + 256 * j); }
    for (int m = gw; m < M; m += NGW) { f32x4 v[8]; float s = 0.f;
#pragma unroll
        for (int j = 0; j < 8; ++j) { v[j] = vn[j]; s += (v[j].x * v[j].x + v[j].y * v[j].y) + (v[j].z * v[j].z + v[j].w * v[j].w); }
        if (m + NGW < M) {
#pragma unroll
            for (int j = 0; j < 8; ++j) vn[j] = *(const f32x4*)(X + (size_t)(m + NGW) * D + 4 * c.lane + 256 * j); }
        const float rstd = rsqrtf(wave_sum(s) * (1.0f / D) + RMS_EPS);
        unsigned char* orow = (unsigned char*)XN + (size_t)m * D * (F8 ? 1 : 2);
#pragma unroll
        for (int j = 0; j < 8; ++j) { v[j] = v[j] * rstd * gg[j];
            if constexpr (F8) { *(unsigned*)(orow + 4 * c.lane + 256 * j) = pk4_fp8(v[j].x, v[j].y, v[j].z, v[j].w); }
            else { u32x2 w; w.x = pk2(v[j].x, v[j].y); w.y = pk2(v[j].z, v[j].w); *(u32x2*)((bf16*)orow + 4 * c.lane + 256 * j) = w; } } }
}
DI float xreduce16(const float (&a)[16], int lane) {
    float b8[8], c4[4], d2[2];
    const bool h5 = (lane & 32) != 0, h4 = (lane & 16) != 0, h3 = (lane & 8) != 0, h2 = (lane & 4) != 0;
#pragma unroll
    for (int i = 0; i < 8; ++i) { const float send = h5 ? a[i] : a[8 + i], keep = h5 ? a[8 + i] : a[i]; b8[i] = keep + __shfl_xor(send, 32); }
#pragma unroll
    for (int i = 0; i < 4; ++i) { const float send = h4 ? b8[i] : b8[4 + i], keep = h4 ? b8[4 + i] : b8[i]; c4[i] = keep + __shfl_xor(send, 16); }
#pragma unroll
    for (int i = 0; i < 2; ++i) { const float send = h3 ? c4[i] : c4[2 + i], keep = h3 ? c4[2 + i] : c4[i]; d2[i] = keep + __shfl_xor(send, 8); }
    const float send = h2 ? d2[0] : d2[1], keep = h2 ? d2[1] : d2[0]; float e = keep + __shfl_xor(send, 4);
    e += __shfl_xor(e, 2); e += __shfl_xor(e, 1);
    return e;
}
DI float xreduce8(const float (&a)[8], int lane) {
    float c4[4], d2[2];
    const bool h5 = (lane & 32) != 0, h4 = (lane & 16) != 0, h3 = (lane & 8) != 0;
#pragma unroll
    for (int i = 0; i < 4; ++i) { const float send = h5 ? a[i] : a[4 + i], keep = h5 ? a[4 + i] : a[i]; c4[i] = keep + __shfl_xor(send, 32); }
#pragma unroll
    for (int i = 0; i < 2; ++i) { const float send = h4 ? c4[i] : c4[2 + i], keep = h4 ? c4[2 + i] : c4[i]; d2[i] = keep + __shfl_xor(send, 16); }
    const float send = h3 ? d2[0] : d2[1], keep = h3 ? d2[1] : d2[0]; float e = keep + __shfl_xor(send, 8);
    e += __shfl_xor(e, 4); e += __shfl_xor(e, 2); e += __shfl_xor(e, 1);
    return e;
}
DI void phase_rms_gates(const Params& p, const Ctx& c) {
    LAS float* WG = (LAS float*)c.lds;
    const float* W = p.in[I_E_W_IN];
    __syncthreads();
    for (int idx = c.tid; idx < D * 16; idx += NTHR) { const int k = idx >> 4, j = idx & 15; WG[j * D + k] = W[(size_t)k * 6160 + 6144 + j]; }
    __syncthreads();
    const int gw = c.bid * NWAVES + c.wave, NGW = c.nb * NWAVES;
    float* GATES = (float*)(p.ws + WS_GATES); bf16* XN = (bf16*)(p.ws + WS_XN);
    const int gi = (c.lane >> 2) & 15;
    const float bias = gi < 8 ? p.in[I_E_B_I][gi & 7] : p.in[I_E_B_F][gi & 7];
    f32x4 gg[8]; rms_ldg(p.in[I_E_NORM_MIX], c.lane, gg);
    for (int m = gw; m < M; m += 2 * NGW) {
        asm volatile("" ::: "memory");
        const bool two = m + NGW < M; const int m1 = two ? m + NGW : m;
        f32x4 v0[8], v1[8];
        rms_row(p.in[I_X] + (size_t)m * D, gg, XN + (size_t)m * D, c.lane, v0);
        rms_row(p.in[I_X] + (size_t)m1 * D, gg, XN + (size_t)m1 * D, c.lane, v1);
#pragma unroll
        for (int j = 0; j < 8; ++j) { *(unsigned*)(p.ws + WS_MIX + (size_t)m * D + 4 * c.lane + 256 * j) = pk4_fp8(v0[j].x, v0[j].y, v0[j].z, v0[j].w);
            *(unsigned*)(p.ws + WS_MIX + (size_t)m1 * D + 4 * c.lane + 256 * j) = pk4_fp8(v1[j].x, v1[j].y, v1[j].z, v1[j].w); }
        float a0[16], a1[16];
#pragma unroll
        for (int jg = 0; jg < 16; ++jg) { float s0 = 0.f, s1 = 0.f;
#pragma unroll
            for (int j = 0; j < 8; ++j) { const f32x4 w = *(const LAS f32x4*)(WG + jg * D + 4 * c.lane + 256 * j);
                s0 += (v0[j].x * w.x + v0[j].y * w.y) + (v0[j].z * w.z + v0[j].w * w.w); s1 += (v1[j].x * w.x + v1[j].y * w.y) + (v1[j].z * w.z + v1[j].w * w.w); }
            a0[jg] = s0; a1[jg] = s1; }
        const float e0 = xreduce16(a0, c.lane), e1 = xreduce16(a1, c.lane);
        if ((c.lane & 3) == 0) { GATES[(size_t)m * 16 + gi] = e0 + bias; if (two) GATES[(size_t)m1 * 16 + gi] = e1 + bias; }
    }
    __syncthreads();
}

DI void phase_conv31(const Params& p, const Ctx& c) {
    const bf16* GLU = (const bf16*)(p.ws + WS_GLU); bf16* MIX = (bf16*)(p.ws + WS_MIX);
    LAS float* T = (LAS float*)c.lds;
    const int ch = 2 * c.tid;
    float w0[31], w1[31];
#pragma unroll
    for (int j = 0; j < 31; ++j) { const f32x2 w = *(const f32x2*)(p.in[I_E_CONV_W] + j * 1024 + ch); w0[j] = w.x; w1[j] = w.y; }
    const f32x2 bb = *(const f32x2*)(p.in[I_E_CONV_B] + ch);
    for (int tile = c.bid; tile < M / 32; tile += c.nb) {
        const int t0 = tile * 32, tl0 = t0 & (SEQ - 1);
        float x0[62], x1[62];
#pragma unroll
        for (int i = 0; i < 62; ++i) { unsigned w = 0u; if (tl0 - 30 + i >= 0) w = *(const unsigned*)(GLU + (size_t)(t0 - 30 + i) * 1024 + ch); x0[i] = bfl(w); x1[i] = bfh(w); }
        __syncthreads();
#pragma unroll
        for (int tt = 0; tt < 32; ++tt) { float a0 = bb.x, a1 = bb.y;
#pragma unroll
            for (int j = 0; j < 31; ++j) { a0 += w0[j] * x0[tt + j]; a1 += w1[j] * x1[tt + j]; }
            *(LAS f32x2*)(T + tt * 1024 + ch) = (f32x2){a0, a1}; }
        __syncthreads();
        f32x4 lg[4], lb[4];
#pragma unroll
        for (int j = 0; j < 4; ++j) { const int cc = 4 * c.lane + 256 * j; lg[j] = *(const f32x4*)(p.in[I_E_LN_G] + cc); lb[j] = *(const f32x4*)(p.in[I_E_LN_B] + cc); }
#pragma unroll
        for (int i = 0; i < 4; ++i) { const int tt = 4 * c.wave + i; f32x4 v[4]; float s = 0.f;
#pragma unroll
            for (int j = 0; j < 4; ++j) { v[j] = *(const LAS f32x4*)(T + tt * 1024 + 4 * c.lane + 256 * j); s += (v[j].x + v[j].y) + (v[j].z + v[j].w); }
            const float mu = wave_sum(s) * (1.0f / 1024.0f); float q = 0.f;
#pragma unroll
            for (int j = 0; j < 4; ++j) { v[j] = v[j] - mu; q += (v[j].x * v[j].x + v[j].y * v[j].y) + (v[j].z * v[j].z + v[j].w * v[j].w); }
            const float rstd = rsqrtf(wave_sum(q) * (1.0f / 1024.0f) + LN_EPS);
#pragma unroll
            for (int j = 0; j < 4; ++j) { const int cc = 4 * c.lane + 256 * j;
                const f32x4 y = v[j] * rstd * lg[j] + lb[j]; u32x2 w; w.x = pk2(silu(y.x), silu(y.y)); w.y = pk2(silu(y.z), silu(y.w));
                *(u32x2*)(MIX + (size_t)(t0 + tt) * 2048 + cc) = w; } }
    }
    __syncthreads();
}

DI float logsig(float x) { return fminf(x, 0.f) - log1pf(__expf(-fabsf(x))); }
DI void qkconv8(const bf16* Z, size_t grow, int pos, int zc, const float* cw, const float* cb, float (&o)[8]) {
    const f32x4 b0 = *(const f32x4*)(cb + zc), b1 = *(const f32x4*)(cb + zc + 4);
    o[0] = b0.x; o[1] = b0.y; o[2] = b0.z; o[3] = b0.w; o[4] = b1.x; o[5] = b1.y; o[6] = b1.z; o[7] = b1.w;
#pragma unroll
    for (int j = 0; j < 4; ++j) { if (pos - 3 + j >= 0) { const u32x4 x = *(const u32x4*)(Z + (grow - 3 + j) * 4096 + zc);
            const f32x4 w0 = *(const f32x4*)(cw + j * 2048 + zc), w1 = *(const f32x4*)(cw + j * 2048 + zc + 4);
            o[0] += w0.x * bfl(x.x); o[1] += w0.y * bfh(x.x); o[2] += w0.z * bfl(x.y); o[3] += w0.w * bfh(x.y); o[4] += w1.x * bfl(x.z); o[5] += w1.y * bfh(x.z); o[6] += w1.z * bfl(x.w); o[7] += w1.w * bfh(x.w); } }
#pragma unroll
    for (int i = 0; i < 8; ++i) o[i] = silu(o[i]);
}
DI void qk_load4(const bf16* Z, size_t grow, int pos, int zc, u32x4 (&x)[4]) {
#pragma unroll
    for (int j = 0; j < 4; ++j) { x[j] = (u32x4){0u, 0u, 0u, 0u}; if (pos - 3 + j >= 0) x[j] = *(const u32x4*)(Z + (grow - 3 + j) * 4096 + zc); }
}
DI void qk_ldw(int zc, const float* cw, const float* cb, f32x4 (&wt)[5][2]) {
#pragma unroll
    for (int j = 0; j < 4; ++j) { wt[j][0] = *(const f32x4*)(cw + j * 2048 + zc); wt[j][1] = *(const f32x4*)(cw + j * 2048 + zc + 4); }
    wt[4][0] = *(const f32x4*)(cb + zc); wt[4][1] = *(const f32x4*)(cb + zc + 4);
}
DI void qk_conv4(const u32x4 (&xx)[4], const f32x4 (&wt)[5][2], float (&o)[8]) {
    const f32x4 b0 = wt[4][0], b1 = wt[4][1];
    o[0] = b0.x; o[1] = b0.y; o[2] = b0.z; o[3] = b0.w; o[4] = b1.x; o[5] = b1.y; o[6] = b1.z; o[7] = b1.w;
#pragma unroll
    for (int j = 0; j < 4; ++j) { const u32x4 x = xx[j];
        const f32x4 w0 = wt[j][0], w1 = wt[j][1];
        o[0] += w0.x * bfl(x.x); o[1] += w0.y * bfh(x.x); o[2] += w0.z * bfl(x.y); o[3] += w0.w * bfh(x.y); o[4] += w1.x * bfl(x.z); o[5] += w1.y * bfh(x.z); o[6] += w1.z * bfl(x.w); o[7] += w1.w * bfh(x.w); }
#pragma unroll
    for (int i = 0; i < 8; ++i) o[i] = silu(o[i]);
}
DI void phase_ml_local(const Params& p, const Ctx& c) {
    unsigned char* ws = p.ws;
    const bf16* Z = (const bf16*)(ws + WS_Z); const float* GATES = (const float*)(ws + WS_GATES);
    bf16* QC = (bf16*)(ws + WS_QC); bf16* KC = (bf16*)(ws + WS_KC);
    float* BCUM = (float*)(ws + WS_BCUM); float* AVAL = (float*)(ws + WS_AVAL); float* BLAST = (float*)(ws + WS_BLAST); float* AMAX = (float*)(ws + WS_AMAX);
    float* CLOC = (float*)(ws + WS_CLOC); float* NLOC = (float*)(ws + WS_NLOC);
    LAS unsigned char* Vt = c.lds; LAS unsigned char* Kt = c.lds + 32768; LAS float* wL = (LAS float*)(c.lds + 65536);
    const float* cw = p.in[I_E_QKCONV_W]; const float* cb = p.in[I_E_QKCONV_B];
    f32x4 gnx = {0.f, 0.f, 0.f, 0.f};
    auto ldg = [&](int unit) __attribute__((always_inline)) { const int b = unit >> 8, h = (unit >> 5) & 7, cc = unit & 31; const size_t t0 = (size_t)b * SEQ + cc * 128; const int t = 2 * c.lane;
        gnx = (f32x4){GATES[(t0 + t) * 16 + 8 + h], GATES[(t0 + t + 1) * 16 + 8 + h], GATES[(t0 + t) * 16 + h], GATES[(t0 + t + 1) * 16 + h]}; };
    if (c.wave == 0 && c.bid < 1024) ldg(c.bid);
    for (int unit = c.bid; unit < 1024; unit += c.nb) {
        const int b = unit >> 8, h = (unit >> 5) & 7, cc = unit & 31, bh = unit >> 5; const size_t t0 = (size_t)b * SEQ + cc * 128;
        __syncthreads();
        if (c.wave == 0) {
            const int t = 2 * c.lane;
            const float f0 = gnx.x, f1 = gnx.y, i0 = gnx.z, i1 = gnx.w;
            if (unit + c.nb < 1024) ldg(unit + c.nb);
            const float l0 = logsig(f0), l1 = logsig(f1); float incl = l0 + l1;
#pragma unroll
            for (int o = 1; o < 64; o <<= 1) { const float y = __shfl_up(incl, o); if (c.lane >= o) incl += y; }
            const float excl = incl - (l0 + l1), b0 = excl + l0, b1 = excl + l0 + l1, a0 = i0 - b0, a1 = i1 - b1;
            const float amax = wave_max(fmaxf(a0, a1)), blast = __shfl(b1, 63);
            wL[t] = __expf(a0 - amax); wL[t + 1] = __expf(a1 - amax);
            *(f32x2*)(BCUM + (size_t)bh * SEQ + cc * 128 + t) = (f32x2){b0, b1}; *(f32x2*)(AVAL + (size_t)bh * SEQ + cc * 128 + t) = (f32x2){a0, a1};
            if (c.lane == 0) { BLAST[unit * 32] = blast; AMAX[unit * 32] = amax; }
        }
        { u32x4 xq[4][4], xv[4]; f32x4 wt[5][2]; qk_ldw(h * 128 + 8 * (c.tid & 15), cw, cb, wt);
#pragma unroll
            for (int i = 0; i < 4; ++i) { const int idx = c.tid + NTHR * i, r = idx >> 4, ch = idx & 15; const size_t grow = t0 + r;
                qk_load4(Z, grow, cc * 128 + r, h * 128 + 8 * ch, xq[i]); xv[i] = *(const u32x4*)(Z + grow * 4096 + 2048 + h * 128 + 8 * ch); }
#pragma unroll
            for (int i = 0; i < 4; ++i) { const int idx = c.tid + NTHR * i, r = idx >> 4, ch = idx & 15; const size_t grow = t0 + r;
                float o[8];
                qk_conv4(xq[i], wt, o);
                { u32x4 w; w.x = pk2(o[0], o[1]); w.y = pk2(o[2], o[3]); w.z = pk2(o[4], o[5]); w.w = pk2(o[6], o[7]); *(u32x4*)(QC + grow * 1024 + h * 128 + 8 * ch) = w; }
                *(LAS u32x4*)(Vt + toff(r, ch)) = xv[i]; } }
        __syncthreads();
        u32x4 xk[4][4]; f32x4 wk[5][2]; qk_ldw(1024 + h * 128 + 8 * (c.tid & 15), cw, cb, wk);
#pragma unroll
        for (int i = 0; i < 4; ++i) { const int idx = c.tid + NTHR * i, r = idx >> 4, ch = idx & 15; qk_load4(Z, t0 + r, cc * 128 + r, 1024 + h * 128 + 8 * ch, xk[i]); }
#pragma unroll
        for (int i = 0; i < 4; ++i) { const int idx = c.tid + NTHR * i, r = idx >> 4, ch = idx & 15; const size_t grow = t0 + r;
            float o[8];
            qk_conv4(xk[i], wk, o);
#pragma unroll
            for (int j = 0; j < 8; ++j) o[j] *= 0.08838834764831845f;
            { u32x4 w; w.x = pk2(o[0], o[1]); w.y = pk2(o[2], o[3]); w.z = pk2(o[4], o[5]); w.w = pk2(o[6], o[7]); *(u32x4*)(KC + grow * 1024 + h * 128 + 8 * ch) = w; }
            const float wr_ = wL[r];
            { u32x4 w; w.x = pk2(o[0] * wr_, o[1] * wr_); w.y = pk2(o[2] * wr_, o[3] * wr_); w.z = pk2(o[4] * wr_, o[5] * wr_); w.w = pk2(o[6] * wr_, o[7] * wr_); *(LAS u32x4*)(Kt + toff(r, ch)) = w; } }
        __syncthreads();
        {
            const int q = c.lane >> 4, tl = c.lane & 15;
            bf16x8 af[4];
#pragma unroll
            for (int ks = 0; ks < 4; ++ks) af[ks] = cat4(ldtr(Vt, 32 * ks + 8 * q, c.wave, c.lane), ldtr(Vt, 32 * ks + 8 * q + 4, c.wave, c.lane));
            float* outp = CLOC + (size_t)unit * 16384;
            s16x4 kfr[2][8];
#pragma unroll
            for (int ks = 0; ks < 4; ++ks) { kfr[0][2 * ks] = ldtr(Kt, 32 * ks + 8 * q, 0, c.lane); kfr[0][2 * ks + 1] = ldtr(Kt, 32 * ks + 8 * q + 4, 0, c.lane); }
#pragma unroll
            for (int db = 0; db < 8; ++db) { f32x4 acc = {0.f, 0.f, 0.f, 0.f};
                if (db < 7) {
#pragma unroll
                    for (int ks = 0; ks < 4; ++ks) { kfr[(db + 1) & 1][2 * ks] = ldtr(Kt, 32 * ks + 8 * q, db + 1, c.lane); kfr[(db + 1) & 1][2 * ks + 1] = ldtr(Kt, 32 * ks + 8 * q + 4, db + 1, c.lane); } }
                __builtin_amdgcn_sched_barrier(0);
#pragma unroll
                for (int ks = 0; ks < 4; ++ks) acc = MFMA16(cat4(kfr[db & 1][2 * ks], kfr[db & 1][2 * ks + 1]), af[ks], acc);
                *(f32x4*)(outp + (16 * c.wave + tl) * 128 + 16 * db + 4 * q) = acc;
                __builtin_amdgcn_sched_barrier(0); }
        }
        {
            const int d = c.tid & 127, part = c.tid >> 7; float s0 = 0.f, s1 = 0.f;
#pragma unroll
            for (int r = 0; r < 32; r += 2) { s0 += bf1(*(const LAS bf16*)(Kt + toff(32 * part + r, d >> 3) + 2 * (d & 7))); s1 += bf1(*(const LAS bf16*)(Kt + toff(32 * part + r + 1, d >> 3) + 2 * (d & 7))); }
            wL[128 + c.tid] = s0 + s1;
            __syncthreads();
            if (c.tid < 128) NLOC[(size_t)unit * 128 + d] = (wL[128 + d] + wL[256 + d]) + (wL[384 + d] + wL[512 + d]); }
    }
    __syncthreads();
}
DI void phase_ml_scan(const Params& p, const Ctx& c) {
    unsigned char* ws = p.ws;
    const float* BLAST = (const float*)(ws + WS_BLAST); const float* AMAX = (const float*)(ws + WS_AMAX); float* MPREV = (float*)(ws + WS_MPREV);
    const float* CLOC = (const float*)(ws + WS_CLOC); const float* NLOC = (const float*)(ws + WS_NLOC); bf16* CPREV = (bf16*)(ws + WS_CPREV); float* NPREV = (float*)(ws + WS_NPREV);
    const int NT = c.nb * NTHR;
    for (int gid = c.bid * NTHR + c.tid; gid < 32 * 4096 + 32 * 128; gid += NT) {
        if (gid < 32 * 4096) {
            const int bh = gid >> 12, e4 = (gid & 4095) * 4; f32x4 C = {0.f, 0.f, 0.f, 0.f}; float m = 0.f;
#pragma unroll 1
            for (int c0 = 0; c0 < 32; c0 += 8) {
                f32x4 L8[8]; float bl8[8], am8[8];
#pragma unroll
                for (int k = 0; k < 8; ++k) { const int u = bh * 32 + c0 + k; L8[k] = *(const f32x4*)(CLOC + (size_t)u * 16384 + e4); bl8[k] = BLAST[u * 32]; am8[k] = AMAX[u * 32]; }
#pragma unroll
                for (int k = 0; k < 8; ++k) { const int u = bh * 32 + c0 + k; const float bl = bl8[k], ml = bl + am8[k];
                    u32x2 w; w.x = pk2(C.x, C.y); w.y = pk2(C.z, C.w); *(u32x2*)(CPREV + (size_t)u * 16384 + e4) = w;
                    if (e4 == 0) MPREV[u] = m;
                    const float mn = fmaxf(bl + m, ml), dec = __expf(bl + m - mn), sc = __expf(ml - mn);
                    C = C * dec + L8[k] * sc; m = mn; } }
        } else {
            const int g2 = gid - 32 * 4096, bh = g2 >> 7, d = g2 & 127; float n = 0.f, m = 0.f;
#pragma unroll 1
            for (int c0 = 0; c0 < 32; c0 += 8) { float n8[8], bl8[8], am8[8];
#pragma unroll
                for (int k = 0; k < 8; ++k) { const int u = bh * 32 + c0 + k; n8[k] = NLOC[(size_t)u * 128 + d]; bl8[k] = BLAST[u * 32]; am8[k] = AMAX[u * 32]; }
#pragma unroll
                for (int k = 0; k < 8; ++k) { const int u = bh * 32 + c0 + k; const float bl = bl8[k], ml = bl + am8[k];
                    NPREV[(size_t)u * 128 + d] = n;
                    const float mn = fmaxf(bl + m, ml), dec = __expf(bl + m - mn), sc = __expf(ml - mn);
                    n = n * dec + n8[k] * sc; m = mn; } }
        }
    }
}
DI void phase_ml_out(const Params& p, const Ctx& c) {
    unsigned char* ws = p.ws;
    const bf16* Z = (const bf16*)(ws + WS_Z); const bf16* QC = (const bf16*)(ws + WS_QC); const bf16* KC = (const bf16*)(ws + WS_KC); const bf16* CPREV = (const bf16*)(ws + WS_CPREV);
    const float* NPREV = (const float*)(ws + WS_NPREV); const float* MPREV = (const float*)(ws + WS_MPREV); const float* BCUM = (const float*)(ws + WS_BCUM); const float* AVAL = (const float*)(ws + WS_AVAL);
    bf16* MIX = (bf16*)(ws + WS_MIX);
    LAS unsigned char* Qt = c.lds; LAS unsigned char* Kt = c.lds + 32768; LAS unsigned char* Vt = c.lds + 65536; LAS unsigned char* Ct = c.lds + 98304;
    LAS float* aL = (LAS float*)(c.lds + 135168); LAS float* ML = aL + 128; LAS float* bL = aL + 256; LAS float* wsc = aL + 384 + c.wave * 32;
    const int q = c.lane >> 4, tl = c.lane & 15, tb = c.wave;
    for (int unit = c.bid; unit < 1024; unit += c.nb) {
        const int b = unit >> 8, h = (unit >> 5) & 7, cc = unit & 31, bh = unit >> 5; const size_t t0 = (size_t)b * SEQ + cc * 128;
        const float mprev = MPREV[unit];
        __syncthreads();
        if (c.wave == 0) { const int t = 2 * c.lane;
            const f32x2 a = *(const f32x2*)(AVAL + (size_t)bh * SEQ + cc * 128 + t), bb = *(const f32x2*)(BCUM + (size_t)bh * SEQ + cc * 128 + t);
            const float pm1 = fmaxf(a.x, a.y); float incl = pm1;
#pragma unroll
            for (int o = 1; o < 64; o <<= 1) { const float y = __shfl_up(incl, o); if (c.lane >= o) incl = fmaxf(incl, y); }
            float excl = __shfl_up(incl, 1); if (c.lane == 0) excl = mprev; excl = fmaxf(excl, mprev);
            aL[t] = a.x; aL[t + 1] = a.y; ML[t] = fmaxf(excl, a.x); ML[t + 1] = fmaxf(excl, pm1); bL[t] = bb.x; bL[t + 1] = bb.y; }
        { u32x4 t4[4][4];
#pragma unroll
            for (int i = 0; i < 4; ++i) { const int idx = c.tid + NTHR * i, r = idx >> 4, ch = idx & 15; const size_t grow = t0 + r;
                t4[i][0] = *(const u32x4*)(QC + grow * 1024 + h * 128 + 8 * ch); t4[i][1] = *(const u32x4*)(KC + grow * 1024 + h * 128 + 8 * ch);
                t4[i][2] = *(const u32x4*)(Z + grow * 4096 + 2048 + h * 128 + 8 * ch); t4[i][3] = *(const u32x4*)(CPREV + (size_t)unit * 16384 + r * 128 + 8 * ch); }
#pragma unroll
            for (int i = 0; i < 4; ++i) { const int idx = c.tid + NTHR * i, r = idx >> 4, ch = idx & 15;
                *(LAS u32x4*)(Qt + toff(r, ch)) = t4[i][0]; *(LAS u32x4*)(Kt + toff(r, ch)) = t4[i][1]; *(LAS u32x4*)(Vt + toff(r, ch)) = t4[i][2]; *(LAS u32x4*)(Ct + toff(r, ch)) = t4[i][3]; } }
        if (c.tid < 256) { const int r = 128 + (c.tid >> 4), ch = c.tid & 15; u32x4 w = {0u, 0u, 0u, 0u};
            if (r == 128) { const f32x4 n0 = *(const f32x4*)(NPREV + (size_t)unit * 128 + 8 * ch), n1 = *(const f32x4*)(NPREV + (size_t)unit * 128 + 8 * ch + 4); w.x = pk2(n0.x, n0.y); w.y = pk2(n0.z, n0.w); w.z = pk2(n1.x, n1.y); w.w = pk2(n1.z, n1.w); }
            *(LAS u32x4*)(Ct + toff(r, ch)) = w; }
        __syncthreads();
        const size_t trow = t0 + 16 * tb + tl;
        u32x2 zo8[8];
#pragma unroll
        for (int eb = 0; eb < 8; ++eb) zo8[eb] = *(const u32x2*)(Z + trow * 4096 + 3072 + h * 128 + 16 * eb + 4 * q);
        bf16x8 qf[4];
#pragma unroll
        for (int ks = 0; ks < 4; ++ks) qf[ks] = ldrow(Qt, 16 * tb + tl, 4 * ks + q);
        const float Mt = ML[16 * tb + tl];
        f32x4 pp[8]; float dsum = 0.f;
#pragma unroll
        for (int sb = 0; sb < 8; ++sb) {
            pp[sb] = (f32x4){0.f, 0.f, 0.f, 0.f};
            if (sb <= tb) { f32x4 acc = {0.f, 0.f, 0.f, 0.f}; bf16x8 kf[4];
#pragma unroll
                for (int ks = 0; ks < 4; ++ks) kf[ks] = ldrow(Kt, 16 * sb + tl, 4 * ks + q);
                __builtin_amdgcn_sched_barrier(0);
#pragma unroll
                for (int ks = 0; ks < 4; ++ks) acc = MFMA16(kf[ks], qf[ks], acc);
                const f32x4 av = *(const LAS f32x4*)(aL + 16 * sb + 4 * q);
#pragma unroll
                for (int i = 0; i < 4; ++i) { const int s = 16 * sb + 4 * q + i, t = 16 * tb + tl; const float w = (s <= t) ? __expf(av[i] - Mt) : 0.f; pp[sb][i] = acc[i] * w; dsum += pp[sb][i]; } }
        }
        dsum += __shfl_xor(dsum, 16); dsum += __shfl_xor(dsum, 32);
        f32x4 o[8];
#pragma unroll
        for (int eb = 0; eb < 8; ++eb) o[eb] = (f32x4){0.f, 0.f, 0.f, 0.f};
#pragma unroll
        for (int kk = 0; kk < 4; ++kk) if (2 * kk <= tb) { const bf16x8 pf = pack8f(pp[2 * kk], pp[2 * kk + 1]);
            s16x4 vf[16];
#pragma unroll
            for (int eb = 0; eb < 8; ++eb) { vf[2 * eb] = ldtr(Vt, 32 * kk + 4 * q, eb, c.lane); vf[2 * eb + 1] = ldtr(Vt, 32 * kk + 16 + 4 * q, eb, c.lane); }
            __builtin_amdgcn_sched_barrier(0);
#pragma unroll
            for (int eb = 0; eb < 8; ++eb) o[eb] = MFMA16(cat4(vf[2 * eb], vf[2 * eb + 1]), pf, o[eb]);
            __builtin_amdgcn_sched_barrier(0); }
        f32x4 ci[9];
#pragma unroll
        for (int e3 = 0; e3 < 9; e3 += 3) { bf16x8 cfr[3][4];
#pragma unroll
            for (int e = 0; e < 3; ++e)
#pragma unroll
                for (int ks = 0; ks < 4; ++ks) cfr[e][ks] = ldrow(Ct, 16 * (e3 + e) + tl, 4 * ks + q);
            __builtin_amdgcn_sched_barrier(0);
#pragma unroll
            for (int e = 0; e < 3; ++e) { ci[e3 + e] = (f32x4){0.f, 0.f, 0.f, 0.f};
#pragma unroll
                for (int ks = 0; ks < 4; ++ks) ci[e3 + e] = MFMA16(cfr[e][ks], qf[ks], ci[e3 + e]); }
            __builtin_amdgcn_sched_barrier(0); }
        const float qn = __shfl(ci[8][0], tl);
        const float bt = bL[16 * tb + tl], wi = __expf(mprev - Mt), den = dsum + wi * qn, inv = 1.0f / fmaxf(fabsf(den), __expf(-(bt + Mt)));
#pragma unroll
        for (int eb = 0; eb < 8; ++eb) { const int col = h * 128 + 16 * eb + 4 * q; const u32x2 zo = zo8[eb];
            const float h0 = (o[eb][0] + wi * ci[eb][0]) * inv, h1 = (o[eb][1] + wi * ci[eb][1]) * inv, h2 = (o[eb][2] + wi * ci[eb][2]) * inv, h3 = (o[eb][3] + wi * ci[eb][3]) * inv;
            u32x2 wv; wv.x = pk2(sigm(bfl(zo.x)) * h0, sigm(bfh(zo.x)) * h1); wv.y = pk2(sigm(bfl(zo.y)) * h2, sigm(bfh(zo.y)) * h3);
            *(u32x2*)(MIX + trow * 2048 + 1024 + col) = wv; }
    }
    __syncthreads();
}

#define GAS __attribute__((address_space(1)))
#define XB_TMO      128
#define XB_XCNT(j)  (256  + 64 * (j))
#define XB_XSUB(j)  (1280 + 64 * (j))
#define XB_XGEN(j)  (2304 + 64 * (j))
#define XB_TOP      3328
#define XB_TOPGEN   3392
#define XCD_BAR_WORDS 3456
#define XB_SPIN_CAP (1u << 18)

__device__ __forceinline__ unsigned xb_ld(unsigned* p)              { return __hip_atomic_load(p, __ATOMIC_RELAXED, __HIP_MEMORY_SCOPE_AGENT); }
__device__ __forceinline__ unsigned xb_add(unsigned* p, unsigned v) { return __hip_atomic_fetch_add(p, v, __ATOMIC_RELAXED, __HIP_MEMORY_SCOPE_AGENT); }
__device__ __forceinline__ unsigned xb_xcc_id() { return (unsigned)__builtin_amdgcn_s_getreg((3 << 11) | 20) & 0xFu; }
#define XB_SPIN(cond, bar) do { unsigned _sp = 0; while (cond) { __builtin_amdgcn_s_sleep(1); \
    if ((++_sp & 255u) == 0u) { if (xb_ld(&(bar)[XB_TMO])) break; if (_sp > XB_SPIN_CAP) { atomicAdd(&(bar)[XB_TMO], 1u); break; } } } } while (0)

struct XcdBarrier {
    unsigned* bar; unsigned x;
    volatile LAS unsigned* st;
};

__device__ __forceinline__ XcdBarrier xcd_barrier_post(unsigned* bar, volatile LAS unsigned* st) {
    XcdBarrier b; b.bar = bar; b.x = xb_xcc_id(); b.st = st;
    if (threadIdx.x == 0) (void)xb_add(&bar[XB_XCNT(b.x)], 1u);
    return b;
}
__device__ __forceinline__ void xcd_barrier_complete(unsigned* bar, unsigned x, unsigned& nloc, unsigned& nx) {
    const unsigned G = gridDim.x * gridDim.y * gridDim.z;
    unsigned sum, cnt, mine, sp = 0u;
    for (;;) {
        sum = 0u; cnt = 0u; mine = 0u;
#pragma unroll
        for (unsigned j = 0; j < 16; ++j) { const unsigned c = xb_ld(&bar[XB_XCNT(j)]); sum += c; cnt += (c > 0u) ? 1u : 0u; mine = (j == x) ? c : mine; }
        if (sum == G) break;
        __builtin_amdgcn_s_sleep(1);
        if ((++sp & 255u) == 0u) { if (xb_ld(&bar[XB_TMO])) break; if (sp > XB_SPIN_CAP) { atomicAdd(&bar[XB_TMO], 1u); break; } }
    }
    nloc = mine > 0u ? mine : 1u; nx = cnt > 0u ? cnt : 1u;
}

__device__ __forceinline__ void xcd_barrier(const XcdBarrier& b) {
    asm volatile("s_waitcnt vmcnt(0)" ::: "memory");
    __syncthreads();
    if (threadIdx.x == 0) {
        unsigned* bar = b.bar;
        __builtin_amdgcn_s_waitcnt(0);
        unsigned nloc = b.st[0], nx = b.st[1];
        if (nloc == 0u) { xcd_barrier_complete(bar, b.x, nloc, nx); b.st[0] = nloc; b.st[1] = nx; }
        const unsigned old = xb_add(&bar[XB_XSUB(b.x)], 1u);
        const unsigned gen = old / nloc;
        if (old + 1u == (gen + 1u) * nloc) {
            __builtin_amdgcn_fence(__ATOMIC_RELEASE, "agent");
            asm volatile("s_waitcnt vmcnt(0)" ::: "memory");
            const unsigned og = xb_add(&bar[XB_TOP], 1u);
            const unsigned tg = og / nx;
            if (og + 1u == (tg + 1u) * nx) xb_add(&bar[XB_TOPGEN], 1u);
            else XB_SPIN(xb_ld(&bar[XB_TOPGEN]) == tg, bar);
            __builtin_amdgcn_fence(__ATOMIC_ACQUIRE, "agent");
            xb_add(&bar[XB_XGEN(b.x)], 1u);
            asm volatile("s_waitcnt vmcnt(0)" ::: "memory");
        } else {
            XB_SPIN(xb_ld(&bar[XB_XGEN(b.x)]) == gen, bar);
            __builtin_amdgcn_fence(__ATOMIC_ACQUIRE, "agent");
            asm volatile("s_waitcnt vmcnt(0)" ::: "memory");
        }
    }
    __syncthreads();
}
DI void at_load(const bf16* QKV, size_t rowb, int ck, int r, int res, int h, int tid, u32x4 (&kv)[4], u32x4 (&vv)[4]) {
    const unsigned lo = ((unsigned)((tid >> 4) * r) * 3072u + 8u * (unsigned)(tid & 15)) * 2u;
#pragma unroll
    for (int i = 0; i < 4; ++i) {
        kv[i] = (u32x4){0u, 0u, 0u, 0u}; vv[i] = (u32x4){0u, 0u, 0u, 0u};
        if (ck >= 0) { const char* ub = (const char*)(QKV + (rowb + (size_t)(128 * ck + 32 * i) * r + res) * 3072 + h * 128); kv[i] = *(const u32x4*)(ub + 2048 + lo); vv[i] = *(const u32x4*)(ub + 4096 + lo); } }
}
DI void at_store(LAS unsigned char* Kt, LAS unsigned char* Vt, int ck, int tid, const u32x4 (&kv)[4], const u32x4 (&vv)[4]) {
    const int base = (ck & 1) * 128;
#pragma unroll
    for (int i = 0; i < 4; ++i) { const int idx = tid + NTHR * i, ki = idx >> 4, ch = idx & 15; *(LAS u32x4*)(Kt + toff(base + ki, ch)) = kv[i]; *(LAS u32x4*)(Vt + toff(base + ki, ch)) = vv[i]; }
}
DI void at_loadq(const bf16* QKV, size_t rowb, int n0, int r, int res, int h, int tl, int q, bf16x8 (&qf)[4]) {
    const char* ub = (const char*)(QKV + (rowb + (size_t)n0 * r + res) * 3072 + h * 128);
    const unsigned lo = ((unsigned)(tl * r) * 3072u + 8u * (unsigned)q) * 2u;
#pragma unroll
    for (int ks = 0; ks < 4; ++ks) qf[ks] = *(const bf16x8*)(ub + lo + 64 * ks);
}
struct AtRun { int g, b, h, res, nbk0, nblk; };
DI void at_decode(int unit, AtRun& R) {
    if (unit < 512) { R.g = unit >> 8; const int idx = unit & 255, rr = idx & 7; R.b = idx >> 6; R.h = (idx >> 3) & 7; R.res = R.g ? (rr >> 1) : 0; R.nbk0 = R.g ? 4 * (rr & 1) : 4 * rr; R.nblk = 4; }
    else { R.g = 2; const int idx = unit - 512; R.b = idx >> 7; R.h = (idx >> 4) & 7; R.res = idx & 15; R.nbk0 = 0; R.nblk = 2; }
}
DI void phase_attn(const Params& p, const Ctx& c) {
    unsigned char* ws = p.ws;
    const bf16* QKV = (const bf16*)(ws + WS_QKV); bf16* OG = (bf16*)(ws + WS_OG); float* MXL = (float*)(ws + WS_MXL);
    LAS unsigned char* Kt = c.lds; LAS unsigned char* Vt = c.lds + 65536;
    const int q = c.lane >> 4, tl = c.lane & 15, w = c.wave;
    int klo[4], vlo[8];
#pragma unroll
    for (int ks = 0; ks < 4; ++ks) klo[ks] = toff(tl, 4 * ks + q);
#pragma unroll
    for (int eb = 0; eb < 8; ++eb) vlo[eb] = toff(4 * q + (tl >> 2), 2 * eb + ((tl & 3) >> 1)) + 8 * (tl & 1);
    u32x4 kv[4], vv[4]; bf16x8 qf[4];
    AtRun R; int unit = c.bid;
    if (unit < 1024) { at_decode(unit, R); at_load(QKV, (size_t)R.b * SEQ, R.nbk0 - 1, 1 << (2 * R.g), R.res, R.h, c.tid, kv, vv); }
    for (; unit < 1024; unit += c.nb) {
        const int g = R.g, b = R.b, h = R.h, res = R.res, nbk0 = R.nbk0, nblk = R.nblk;
        const int lr = 2 * g, r = 1 << lr;
        const size_t rowb = (size_t)b * SEQ;
        const bool more = unit + c.nb < 1024;
        __syncthreads();
        at_store(Kt, Vt, nbk0 - 1, c.tid, kv, vv);
        at_load(QKV, rowb, nbk0, r, res, h, c.tid, kv, vv);
        at_loadq(QKV, rowb, 128 * nbk0 + 16 * w, r, res, h, tl, q, qf);
        for (int j = 0; j < nblk; ++j) {
            const int nbk = nbk0 + j;
            if (j) __syncthreads();
            at_store(Kt, Vt, nbk, c.tid, kv, vv);
            __syncthreads();
            const int nq = 128 * nbk + 16 * w + tl;
            const size_t qrow = rowb + (size_t)nq * r + res;
            if (j + 1 < nblk) at_load(QKV, rowb, nbk + 1, r, res, h, c.tid, kv, vv);
            else if (more) { at_decode(unit + c.nb, R); at_load(QKV, (size_t)R.b * SEQ, R.nbk0 - 1, 1 << (2 * R.g), R.res, R.h, c.tid, kv, vv); }
#ifdef PROBE_ATTC
#pragma unroll 1
            for (int rep2 = 0; rep2 < 2; ++rep2) { asm volatile("" ::: "memory");
#endif
            const int f8 = ((nbk - 1) & 1) << 3;
            const int kb0 = 2 * (w >> 1), qi = 16 * w + tl;
            const int lo2 = nbk == 0 ? 128 - qi : 0, d0 = 16 * kb0 + 4 * q - qi - lo2; const unsigned hb = (unsigned)(128 - lo2);
            f32x4 sc[10]; float mx = -3.0e38f;
            bf16x8 kf[2][8];
#pragma unroll
            for (int s2 = 0; s2 < 2; ++s2)
#pragma unroll
                for (int ks = 0; ks < 4; ++ks) kf[0][4 * s2 + ks] = *(const LAS bf16x8*)(Kt + (((kb0 + s2) ^ f8) << 12) + klo[ks]);
#pragma unroll
            for (int pp = 0; pp < 5; ++pp) {
                if (pp < 4) {
#pragma unroll
                    for (int s2 = 0; s2 < 2; ++s2)
#pragma unroll
                        for (int ks = 0; ks < 4; ++ks) kf[(pp + 1) & 1][4 * s2 + ks] = *(const LAS bf16x8*)(Kt + (((kb0 + 2 * pp + 2 + s2) ^ f8) << 12) + klo[ks]); }
                __builtin_amdgcn_sched_barrier(0);
#pragma unroll
                for (int s2 = 0; s2 < 2; ++s2) { const int sb = 2 * pp + s2; f32x4 acc = {0.f, 0.f, 0.f, 0.f};
#pragma unroll
                    for (int ks = 0; ks < 4; ++ks) acc = MFMA16(kf[pp & 1][4 * s2 + ks], qf[ks], acc);
#pragma unroll
                    for (int i = 0; i < 4; ++i) { const bool ok = (unsigned)(d0 + 16 * sb + i) <= hb;
                        acc[i] = ok ? acc[i] : -3.0e38f; mx = fmaxf(mx, acc[i]); }
                    sc[sb] = acc; }
                __builtin_amdgcn_sched_barrier(0);
            }
            s16x4 vf[2][16];
#pragma unroll
            for (int eb = 0; eb < 8; ++eb) { vf[0][2 * eb] = __builtin_bit_cast(s16x4, __builtin_amdgcn_ds_read_tr16_b64_v4i16((LAS s16x4*)(Vt + (((kb0) ^ f8) << 12) + vlo[eb])));
                vf[0][2 * eb + 1] = __builtin_bit_cast(s16x4, __builtin_amdgcn_ds_read_tr16_b64_v4i16((LAS s16x4*)(Vt + (((kb0 + 1) ^ f8) << 12) + vlo[eb]))); }
            __builtin_amdgcn_sched_barrier(0);
#ifndef PROBE_ATTC
            if (j + 1 < nblk) at_loadq(QKV, rowb, 128 * (nbk + 1) + 16 * w, r, res, h, tl, q, qf);
#endif
            mx = fmaxf(mx, __shfl_xor(mx, 16)); mx = fmaxf(mx, __shfl_xor(mx, 32));
            float l = 0.f; const float mxl = -1.4426950408889634f * mx;
#pragma unroll
            for (int sb = 0; sb < 10; ++sb)
#pragma unroll
                for (int i = 0; i < 4; ++i) { const float e = __builtin_amdgcn_exp2f(__builtin_fmaf(sc[sb][i], 1.4426950408889634f, mxl)); sc[sb][i] = e; l += e; }
            l += __shfl_xor(l, 16); l += __shfl_xor(l, 32);
            f32x4 o[8];
#pragma unroll
            for (int eb = 0; eb < 8; ++eb) o[eb] = (f32x4){0.f, 0.f, 0.f, 0.f};
#pragma unroll
            for (int kk = 0; kk < 5; ++kk) { const bf16x8 pf = pack8f(sc[2 * kk], sc[2 * kk + 1]);
                if (kk < 4) {
#pragma unroll
                    for (int eb = 0; eb < 8; ++eb) { vf[(kk + 1) & 1][2 * eb] = __builtin_bit_cast(s16x4, __builtin_amdgcn_ds_read_tr16_b64_v4i16((LAS s16x4*)(Vt + (((kb0 + 2 * kk + 2) ^ f8) << 12) + vlo[eb])));
                        vf[(kk + 1) & 1][2 * eb + 1] = __builtin_bit_cast(s16x4, __builtin_amdgcn_ds_read_tr16_b64_v4i16((LAS s16x4*)(Vt + (((kb0 + 2 * kk + 3) ^ f8) << 12) + vlo[eb]))); } }
                __builtin_amdgcn_sched_barrier(0);
#pragma unroll
                for (int eb = 0; eb < 8; ++eb) o[eb] = MFMA16(cat4(vf[kk & 1][2 * eb], vf[kk & 1][2 * eb + 1]), pf, o[eb]);
                __builtin_amdgcn_sched_barrier(0); }
            if (q == 0) *(f32x2*)(MXL + ((((size_t)(g * 4 + b) * 8 + h) * SEQ) + (size_t)res * (SEQ >> lr) + nq) * 2) = (f32x2){mx, l};
            bf16* og = OG + (size_t)g * M * 1024 + qrow * 1024 + h * 128 + 4 * q;
#pragma unroll
            for (int eb = 0; eb < 8; ++eb) { u32x2 wv; wv.x = pk2(o[eb][0], o[eb][1]); wv.y = pk2(o[eb][2], o[eb][3]); *(u32x2*)(og + 16 * eb) = wv; }
#ifdef PROBE_ATTC
            }
#endif
        }
    }
    __syncthreads();
}
DI void phase_attn_merge(const Params& p, const Ctx& c) {
    unsigned char* ws = p.ws; const bf16* OG = (const bf16*)(ws + WS_OG); const float* MXL = (const float*)(ws + WS_MXL); bf16* MIX = (bf16*)(ws + WS_MIX);
    const int NT = c.nb * NTHR;
    for (int idx0 = c.bid * NTHR + c.tid; idx0 < M * 128; idx0 += 4 * NT) {
        f32x2 ml[4][3]; u32x4 x[4][3];
#pragma unroll
        for (int i = 0; i < 4; ++i) { const int idx = idx0 + i * NT < M * 128 ? idx0 + i * NT : idx0; const int t = idx >> 7, hc = idx & 127, h = hc >> 4;
#pragma unroll
            for (int g = 0; g < 3; ++g) { const int lr = 2 * g, bq = t >> 12, pos = t & (SEQ - 1), res = pos & ((1 << lr) - 1), n = pos >> lr;
                ml[i][g] = *(const f32x2*)(MXL + ((((size_t)(g * 4 + bq) * 8 + h) * SEQ) + (size_t)res * (SEQ >> lr) + n) * 2);
                x[i][g] = *(const u32x4*)(OG + ((size_t)g * M + t) * 1024 + 8 * hc); } }
#pragma unroll
        for (int i = 0; i < 4; ++i) { const int idx = idx0 + i * NT; if (idx >= M * 128) break; const int t = idx >> 7, hc = idx & 127;
            const float MX = fmaxf(fmaxf(ml[i][0].x, ml[i][1].x), ml[i][2].x);
            float wg[3], den = 0.f;
#pragma unroll
            for (int g = 0; g < 3; ++g) { wg[g] = __expf(ml[i][g].x - MX); den += wg[g] * ml[i][g].y; }
            const float inv = 1.0f / den; float a[8] = {0.f, 0.f, 0.f, 0.f, 0.f, 0.f, 0.f, 0.f};
#pragma unroll
            for (int g = 0; g < 3; ++g) { const u32x4 xx = x[i][g]; const float sw = wg[g] * inv;
                a[0] += sw * bfl(xx.x); a[1] += sw * bfh(xx.x); a[2] += sw * bfl(xx.y); a[3] += sw * bfh(xx.y); a[4] += sw * bfl(xx.z); a[5] += sw * bfh(xx.z); a[6] += sw * bfl(xx.w); a[7] += sw * bfh(xx.w); }
            u32x4 o; o.x = pk2(a[0], a[1]); o.y = pk2(a[2], a[3]); o.z = pk2(a[4], a[5]); o.w = pk2(a[6], a[7]);
            *(u32x4*)(MIX + (size_t)t * 2048 + 8 * hc) = o; }
    }
}

DI void cmul_add(float& xr, float& xi, float lr, float li, float br, float bi) {
    float nr = __builtin_fmaf(lr, xr, __builtin_fmaf(-li, xi, br)), ni = __builtin_fmaf(lr, xi, __builtin_fmaf(li, xr, bi));
    asm volatile("" : "+v"(nr), "+v"(ni));
    xr = nr; xi = ni; }
DI void phase_s5(const Params& p, const Ctx& c) {
    unsigned char* ws = p.ws; const bf16* U = (const bf16*)(ws + WS_U); bf16* Y = (bf16*)(ws + WS_Y);
    LAS unsigned char* Xw = c.lds + c.wave * 8192; LAS float* endL = (LAS float*)(c.lds + 65536);
    const int j = c.lane & 31, hh = c.lane >> 5, q4 = c.lane >> 4, tl = c.lane & 15, w = c.wave;
    for (int unit = c.bid; unit < 256; unit += c.nb) {
        const int b = unit >> 6, g = unit & 63;
        const float dt = __expf(p.in[I_O_LOG_DT][g]);
        float lbr[2], lbi[2], L256r[2], L256i[2]; bf16x8 bfr[4];
#pragma unroll
        for (int s = 0; s < 2; ++s) { const int st = g * 64 + 32 * s + j; const float lr = p.in[I_O_LAM_RE][st], li = p.in[I_O_LAM_IM][st];
            const float mag = expf(lr * dt); float sn, cs; sincosf(li * dt, &sn, &cs); lbr[s] = mag * cs; lbi[s] = mag * sn;
            const float dn = 1.0f / (lr * lr + li * li), cr = ((lbr[s] - 1.0f) * lr + lbi[s] * li) * dn, cim = (lbi[s] * lr - (lbr[s] - 1.0f) * li) * dn;
            const f32x4 br0 = *(const f32x4*)(p.in[I_O_B_RE] + (size_t)st * 16 + 8 * hh), br1 = *(const f32x4*)(p.in[I_O_B_RE] + (size_t)st * 16 + 8 * hh + 4);
            const f32x4 bi0 = *(const f32x4*)(p.in[I_O_B_IM] + (size_t)st * 16 + 8 * hh), bi1 = *(const f32x4*)(p.in[I_O_B_IM] + (size_t)st * 16 + 8 * hh + 4);
            bfr[s] = pack8f(br0 * cr - bi0 * cim, br1 * cr - bi1 * cim); bfr[2 + s] = pack8f(bi0 * cr + br0 * cim, bi1 * cr + br1 * cim);
            float pr = lbr[s], pi = lbi[s];
#pragma unroll
            for (int k = 0; k < 8; ++k) { const float nr = pr * pr - pi * pi, ni = 2.0f * pr * pi; pr = nr; pi = ni; }
            L256r[s] = pr; L256i[s] = pi; }
        bf16x8 cf[4];
#pragma unroll
        for (int ks = 0; ks < 4; ++ks) { const size_t o = ((size_t)g * 16 + tl) * 64 + 16 * ks + 4 * q4; const f32x4 cr = *(const f32x4*)(p.in[I_O_C_RE] + o), ci = *(const f32x4*)(p.in[I_O_C_IM] + o);
            u32x4 wv; wv.x = pk2m(cr.x, -ci.x); wv.y = pk2m(cr.y, -ci.y); wv.z = pk2m(cr.z, -ci.z); wv.w = pk2m(cr.w, -ci.w); cf[ks] = __builtin_bit_cast(bf16x8, wv); }
        const f32x4 dsk4 = *(const f32x4*)(p.in[I_O_D_SKIP] + 16 * g + 4 * q4);
        const size_t rowb = (size_t)b * SEQ;
        const int arow = c.lane & 31, akh = c.lane >> 5;
        const size_t atok0 = rowb + 256 * (2 * w + ((arow >> 2) & 1)) + 4 * (arow >> 3) + (arow & 3);
        const f32x16 z16 = {0.f, 0.f, 0.f, 0.f, 0.f, 0.f, 0.f, 0.f, 0.f, 0.f, 0.f, 0.f, 0.f, 0.f, 0.f, 0.f};
        float xr[2] = {0.f, 0.f}, xi[2] = {0.f, 0.f};
        bf16x8 ur[4];
#pragma unroll
        for (int k = 0; k < 4; ++k) ur[k] = *(const bf16x8*)(U + (atok0 + 16 * k) * 1024 + 16 * g + 8 * akh);
#pragma unroll 1
        for (int it0 = 0; it0 < 16; it0 += 4) {
#pragma unroll
            for (int k = 0; k < 4; ++k) { const bf16x8 uf = ur[k]; ur[k] = *(const bf16x8*)(U + (atok0 + 16 * ((it0 + k + 4) & 15)) * 1024 + 16 * g + 8 * akh);
                const f32x16 b0 = MFMA32(uf, bfr[0], z16), b1 = MFMA32(uf, bfr[1], z16), b2 = MFMA32(uf, bfr[2], z16), b3 = MFMA32(uf, bfr[3], z16);
#pragma unroll
                for (int r = 0; r < 16; ++r) { cmul_add(xr[0], xi[0], lbr[0], lbi[0], b0[r], b2[r]); cmul_add(xr[1], xi[1], lbr[1], lbi[1], b1[r], b3[r]); } } }
        u32x2 uu0[4][2];
#pragma unroll
        for (int jt = 0; jt < 4; ++jt)
#pragma unroll
            for (int sc = 0; sc < 2; ++sc) uu0[jt][sc] = *(const u32x2*)(U + (rowb + 256 * (2 * w + sc) + 16 * jt + tl) * 1024 + 16 * g + 4 * q4);
        __syncthreads();
        { const int ss = 2 * w + hh; *(LAS f32x2*)(endL + (ss * 64 + j) * 2) = (f32x2){xr[0], xi[0]}; *(LAS f32x2*)(endL + (ss * 64 + 32 + j) * 2) = (f32x2){xr[1], xi[1]}; }
        __syncthreads();
        { const int ss = 2 * w + hh; xr[0] = xi[0] = xr[1] = xi[1] = 0.f;
            for (int s2 = 0; s2 < ss; ++s2) { const f32x2 e0 = *(const LAS f32x2*)(endL + (s2 * 64 + j) * 2), e1 = *(const LAS f32x2*)(endL + (s2 * 64 + 32 + j) * 2);
                cmul_add(xr[0], xi[0], L256r[0], L256i[0], e0.x, e0.y); cmul_add(xr[1], xi[1], L256r[1], L256i[1], e1.x, e1.y); } }
        auto trip = [&](int it4, const bf16x8 (&u4)[4], const u32x2 (&uu4)[4][2]) __attribute__((always_inline)) {
#pragma unroll
            for (int jt = 0; jt < 4; ++jt) { const int it = 4 * it4 + jt; const bf16x8 uf = u4[jt];
                const f32x16 b0 = MFMA32(uf, bfr[0], z16), b1 = MFMA32(uf, bfr[1], z16), b2 = MFMA32(uf, bfr[2], z16), b3 = MFMA32(uf, bfr[3], z16);
#pragma unroll
                for (int r = 0; r < 16; ++r) { cmul_add(xr[0], xi[0], lbr[0], lbi[0], b0[r], b2[r]); cmul_add(xr[1], xi[1], lbr[1], lbi[1], b1[r], b3[r]);
                    const int row = 16 * hh + r;
                    *(LAS unsigned*)(Xw + toff(row, j >> 2) + 4 * (j & 3)) = pk2(xr[0], xi[0]);
                    *(LAS unsigned*)(Xw + toff(row, 8 + (j >> 2)) + 4 * (j & 3)) = pk2(xr[1], xi[1]); }
                LDS_WAIT();
                bf16x8 xs[2][4];
#pragma unroll
                for (int sc = 0; sc < 2; ++sc)
#pragma unroll
                    for (int ks = 0; ks < 4; ++ks) xs[sc][ks] = ldrow(Xw, 16 * sc + tl, 4 * ks + q4);
                __builtin_amdgcn_sched_barrier(0);
#pragma unroll
                for (int sc = 0; sc < 2; ++sc) { f32x4 acc = {0.f, 0.f, 0.f, 0.f};
#pragma unroll
                    for (int ks = 0; ks < 4; ++ks) acc = MFMA16(cf[ks], xs[sc][ks], acc);
                    const size_t t = rowb + 256 * (2 * w + sc) + 16 * it + tl; const size_t o = t * 1024 + 16 * g + 4 * q4; const u32x2 uu = uu4[jt][sc];
                    float y[4] = {acc[0] + dsk4.x * bfl(uu.x), acc[1] + dsk4.y * bfh(uu.x), acc[2] + dsk4.z * bfl(uu.y), acc[3] + dsk4.w * bfh(uu.y)};
#pragma unroll
                    for (int i = 0; i < 4; ++i) { const float z = 1.5957691216057308f * (y[i] + 0.044715f * y[i] * y[i] * y[i]); y[i] = y[i] * sigm(z); }
                    __hip_atomic_store((unsigned long long*)(Y + o), ((unsigned long long)pk2(y[2], y[3]) << 32) | (unsigned long long)pk2(y[0], y[1]), __ATOMIC_RELAXED, __HIP_MEMORY_SCOPE_AGENT); }
                LDS_WAIT(); }
        };
        trip(0, ur, uu0);
#pragma unroll 1
        for (int it4 = 1; it4 < 4; ++it4) {
            bf16x8 u4[4]; u32x2 uu4[4][2];
#pragma unroll
            for (int jt = 0; jt < 4; ++jt) { const int it = 4 * it4 + jt; u4[jt] = *(const bf16x8*)(U + (atok0 + 16 * it) * 1024 + 16 * g + 8 * akh);
#pragma unroll
                for (int sc = 0; sc < 2; ++sc) uu4[jt][sc] = *(const u32x2*)(U + (rowb + 256 * (2 * w + sc) + 16 * it + tl) * 1024 + 16 * g + 4 * q4); }
            trip(it4, u4, uu4);
        }
        __syncthreads();
    }
}

DI void phase_route(const Params& p, const Ctx& c) {
    unsigned char* ws = p.ws; LAS float* WR = (LAS float*)c.lds; LAS int* cntL = (LAS int*)(c.lds + 65536);
    int* TOKE = (int*)(ws + WS_TOKE); float* TOKG = (float*)(ws + WS_TOKG); int* CNT = (int*)(ws + WS_CNT); bf16* XN = (bf16*)(ws + WS_XN);
    __syncthreads();
    for (int idx = c.tid; idx < D * 8; idx += NTHR) { const int k = idx >> 3, e = idx & 7; WR[e * D + k] = p.in[I_O_ROUTER][idx]; }
    f32x4 gg[8]; rms_ldg(p.in[I_O_NORM_FFN], c.lane, gg);
    for (int tb = c.bid; tb < 256; tb += c.nb) {
        __syncthreads();
        if (c.tid < 8) cntL[c.tid] = 0;
        __syncthreads();
        for (int i = 0; i < 8; i += 2) { const int m = 64 * tb + 8 * c.wave + i;
            asm volatile("" ::: "memory");
            f32x4 va[8], vb[8]; rms_row<true>(p.out + (size_t)m * D, gg, (unsigned char*)XN + (size_t)m * D, c.lane, va);
            rms_row<true>(p.out + (size_t)(m + 1) * D, gg, (unsigned char*)XN + (size_t)(m + 1) * D, c.lane, vb);
            float aa[8], ab[8];
#pragma unroll
            for (int e = 0; e < 8; ++e) { float s0 = 0.f, s1 = 0.f;
#pragma unroll
                for (int jj = 0; jj < 8; ++jj) { const f32x4 wv = *(const LAS f32x4*)(WR + e * D + 4 * c.lane + 256 * jj);
                    s0 += (va[jj].x * wv.x + va[jj].y * wv.y) + (va[jj].z * wv.z + va[jj].w * wv.w); s1 += (vb[jj].x * wv.x + vb[jj].y * wv.y) + (vb[jj].z * wv.z + vb[jj].w * wv.w); }
                aa[e] = s0; ab[e] = s1; }
            const float ea = xreduce8(aa, c.lane), eb = xreduce8(ab, c.lane);
#pragma unroll
            for (int rr = 0; rr < 2; ++rr) { const float ev = rr ? eb : ea; float lg[8];
#pragma unroll
                for (int e = 0; e < 8; ++e) lg[e] = __builtin_bit_cast(float, __builtin_amdgcn_readlane(__builtin_bit_cast(int, ev), 8 * e));
                int i1 = 0; float v1 = lg[0];
#pragma unroll
                for (int e = 1; e < 8; ++e) if (lg[e] > v1) { v1 = lg[e]; i1 = e; }
                int i2 = -1; float v2 = -3.0e38f;
#pragma unroll
                for (int e = 0; e < 8; ++e) if (e != i1 && lg[e] > v2) { v2 = lg[e]; i2 = e; }
                if (c.lane == 0) { const float g1 = 1.0f / (1.0f + expf(v2 - v1)); *(int2*)(TOKE + 2 * (m + rr)) = make_int2(i1, i2); *(f32x2*)(TOKG + 2 * (m + rr)) = (f32x2){g1, 1.0f - g1};
                    atomicAdd((int*)(cntL + i1), 1); atomicAdd((int*)(cntL + i2), 1); } } }
        __syncthreads();
        if (c.tid < 8) CNT[tb * 32 + c.tid] = cntL[c.tid];
    }
    __syncthreads();
}
DI void phase_assign(const Params& p, const Ctx& c) {
    unsigned char* ws = p.ws; const int* TOKE = (const int*)(ws + WS_TOKE); int* SLOT = (int*)(ws + WS_SLOT); const int* CNT = (const int*)(ws + WS_CNT); int* TILEE = (int*)(ws + WS_TILEE);
    const bf16* XN = (const bf16*)(ws + WS_XN); bf16* XG = (bf16*)(ws + WS_XG);
    LAS int* cL = (LAS int*)c.lds; LAS int* tot = cL + 2048; LAS int* pre = tot + 8; LAS int* slotL = pre + 8;
    for (int tb = c.bid; tb < 256; tb += c.nb) {
        __syncthreads();
        for (int i = c.tid; i < 2048; i += NTHR) cL[i] = CNT[(i >> 3) * 32 + (i & 7)];
        __syncthreads();
        {
            const int e = c.wave; int t = 0, pr = 0;
#pragma unroll
            for (int k = 0; k < 4; ++k) { const int bb = 4 * c.lane + k, v = cL[bb * 8 + e]; t += v; pr += bb < tb ? v : 0; }
#pragma unroll
            for (int o = 1; o < 64; o <<= 1) { t += __shfl_xor(t, o); pr += __shfl_xor(pr, o); }
            if (c.lane == 0) { tot[e] = t; pre[e] = pr; } }
        __syncthreads();
        int base[8]; { int a = 0;
#pragma unroll
            for (int e = 0; e < 8; ++e) { base[e] = a; a += (tot[e] + 255) & ~255; } }
        if (c.wave == 0) { const int m = 64 * tb + c.lane; const int2 ee = *(const int2*)(TOKE + 2 * m); int s1 = 0, s2 = 0;
#pragma unroll
            for (int e = 0; e < 8; ++e) { const bool sel = (ee.x == e) || (ee.y == e); const unsigned long long bal = __ballot(sel);
                const int rank = __popcll(bal & ((1ull << c.lane) - 1ull)); const int sl = base[e] + pre[e] + rank; if (ee.x == e) s1 = sl; if (ee.y == e) s2 = sl; }
            *(int2*)(SLOT + 2 * m) = make_int2(s1, s2); slotL[2 * c.lane] = s1; slotL[2 * c.lane + 1] = s2; }
        __syncthreads();
        for (int rr0 = c.wave; rr0 < 128; rr0 += 4 * NWAVES) {
            u32x4 t[4][2];
#pragma unroll
            for (int i = 0; i < 4; ++i) { const int rr = rr0 + NWAVES * i, m = 64 * tb + (rr >> 1); const u32x4* src = (const u32x4*)((const unsigned char*)XN + (size_t)m * D);
#pragma unroll
                for (int k = 0; k < 2; ++k) t[i][k] = src[c.lane + 64 * k]; }
#pragma unroll
            for (int i = 0; i < 4; ++i) { const int rr = rr0 + NWAVES * i; u32x4* dst = (u32x4*)((unsigned char*)XG + (size_t)slotL[rr] * D);
#pragma unroll
                for (int k = 0; k < 2; ++k) dst[c.lane + 64 * k] = t[i][k]; } }
        if (tb < 8) {
            const int e = tb, r0 = base[e] + tot[e], r1 = base[e] + ((tot[e] + 255) & ~255);
            for (int rr = r0 + c.wave; rr < r1; rr += NWAVES) { u32x4* dst = (u32x4*)((unsigned char*)XG + (size_t)rr * D);
#pragma unroll
                for (int k = 0; k < 2; ++k) dst[c.lane + 64 * k] = (u32x4){0u, 0u, 0u, 0u}; } }
        if (tb == 0 && c.tid < 256) { int nt = 0, mye = 0;
#pragma unroll
            for (int e = 0; e < 8; ++e) { const int n = (tot[e] + 255) >> 8; if (c.tid >= nt && c.tid < nt + n) mye = e; nt += n; }
            TILEE[c.tid] = (c.tid == 255) ? nt : mye; }
    }
    __syncthreads();
}
DI void phase_final(const Params& p, const Ctx& c) {
    unsigned char* ws = p.ws; const int* SLOT = (const int*)(ws + WS_SLOT); const float* TOKG = (const float*)(ws + WS_TOKG); const bf16* YG = (const bf16*)(ws + WS_XG);
    const int gw = c.bid * NWAVES + c.wave, NGW = c.nb * NWAVES;
    f32x4 gg[8]; rms_ldg(p.in[I_FINAL_NORM], c.lane, gg);
    int2 sln = make_int2(0, 0); f32x2 gtn = {0.f, 0.f};
    if (gw < M) { sln = *(const int2*)(SLOT + 2 * gw); gtn = *(const f32x2*)(TOKG + 2 * gw); }
    for (int m = gw; m < M; m += NGW) { const int2 sl = sln; const f32x2 gt = gtn;
        if (m + NGW < M) { sln = *(const int2*)(SLOT + 2 * (m + NGW)); gtn = *(const f32x2*)(TOKG + 2 * (m + NGW)); }
        float* xrow = p.out + (size_t)m * D; const bf16* y1 = YG + (size_t)sl.x * D; const bf16* y2 = YG + (size_t)sl.y * D;
        f32x4 v[8]; float s = 0.f;
#pragma unroll
        for (int j = 0; j < 8; ++j) { const int k = 4 * c.lane + 256 * j; v[j] = *(const f32x4*)(xrow + k); const u32x2 a = *(const u32x2*)(y1 + k), bq = *(const u32x2*)(y2 + k);
            v[j].x += gt.x * bfl(a.x) + gt.y * bfl(bq.x); v[j].y += gt.x * bfh(a.x) + gt.y * bfh(bq.x); v[j].z += gt.x * bfl(a.y) + gt.y * bfl(bq.y); v[j].w += gt.x * bfh(a.y) + gt.y * bfh(bq.y);
            s += (v[j].x * v[j].x + v[j].y * v[j].y) + (v[j].z * v[j].z + v[j].w * v[j].w); }
        const float rstd = rsqrtf(wave_sum(s) * (1.0f / D) + RMS_EPS);
#pragma unroll
        for (int j = 0; j < 8; ++j) { const int k = 4 * c.lane + 256 * j; *(f32x4*)(xrow + k) = v[j] * rstd * gg[j]; } }
}
constexpr int NPHASE = 19;
constexpr int SC_ONE = 0x7F7F7F7F, SC_W = 0x79797979  , SC_H = 0x7C7C7C7C  ;
#ifndef PROBE_MASK
#define PROBE_MASK 0u
#endif
#define REPS(k) (1 + (int)((PROBE_MASK >> (k)) & 1u))
__global__ void __launch_bounds__(NTHR, 2) mega(Params p) {
    extern __shared__ __attribute__((aligned(16))) unsigned char lds_[];
    Ctx c; c.lds = (LAS unsigned char*)lds_; c.tid = threadIdx.x; c.lane = c.tid & 63; c.wave = __builtin_amdgcn_readfirstlane(c.tid >> 6); c.bid = blockIdx.x; c.nb = gridDim.x;
    unsigned char* ws = p.ws;
    volatile LAS unsigned* MISC = (volatile LAS unsigned*)(c.lds + MISC_OFF);
    if (c.tid < 64) MISC[c.tid] = 0u;
    __syncthreads();
    XcdBarrier bar; bar.bar = (unsigned*)(ws + WS_CTL) + CW_BAR; bar.x = 0; bar.st = nullptr;
    if (p.hi - p.lo > 1) bar = xcd_barrier_post((unsigned*)(ws + WS_CTL) + CW_BAR, MISC + 8);
#ifndef PH_MASK
#define PH_MASK 0x7FFFFu
#endif
#define IN(k) (((PH_MASK >> (k)) & 1u) && p.lo <= (k) && (k) < p.hi)
#define SEAM(k) do { if (IN(k) && IN((k) + 1)) xcd_barrier(bar); } while (0)
    bf16* XN = (bf16*)(ws + WS_XN); bf16* MIX = (bf16*)(ws + WS_MIX);
    const int* TILEE = (const int*)(ws + WS_TILEE);

    if (IN(0)) for (int rep_ = 0; rep_ < REPS(0); ++rep_) { phase_convert(p, c); phase_rms_gates(p, c); } SEAM(0);
    if (IN(1)) for (int rep_ = 0; rep_ < REPS(1); ++rep_) {
        { pg8::Gemm g{XN, (const bf16*)(ws + WS_W0IN), M, 2048, D}; pg8::StaticOrder S; S.init(M, 2048, c.nb, c.bid); pg8::EpiL0In E{(bf16*)(ws + WS_GLU), (bf16*)(ws + WS_Z), 0};
          pg8::gemm_phase<pg8::EpiL0In, pg8::StaticOrder, true, true>(c.lds, g, S, E); }
        { pg8::Gemm g{MIX, (const bf16*)(ws + WS_W0IN + 12 * MiB), M, 4096, D / 2, SC_ONE, SC_W}; pg8::StaticOrder S; S.init(M, 4096, c.nb, c.bid); pg8::EpiPlain E{(bf16*)(ws + WS_Z), 4096};
          pg8::gemm_phase<pg8::EpiPlain, pg8::StaticOrder, true, true, true>(c.lds, g, S, E); } } SEAM(1);
    if (IN(2)) for (int rep_ = 0; rep_ < REPS(2); ++rep_) { phase_conv31(p, c); phase_ml_local(p, c); } SEAM(2);
    if (IN(3)) for (int rep_ = 0; rep_ < REPS(3); ++rep_) { phase_ml_scan(p, c); } SEAM(3);
    if (IN(4)) for (int rep_ = 0; rep_ < REPS(4); ++rep_) { phase_ml_out(p, c); } SEAM(4);
    if (IN(5)) for (int rep_ = 0; rep_ < REPS(5); ++rep_) { pg8::Gemm g{MIX, (const bf16*)(ws + WS_W0OUT), M, D, D}; pg8::StaticOrder S; S.init(M, D, c.nb, c.bid); pg8::EpiResid E{p.in[I_X], p.out, D};
        pg8::gemm_phase<pg8::EpiResid, pg8::StaticOrder, true, true>(c.lds, g, S, E); } SEAM(5);
    if (IN(6)) for (int rep_ = 0; rep_ < REPS(6); ++rep_) { phase_rms<false>(p.out, p.in[I_E_NORM_FFN], XN, c); } SEAM(6);
    if (IN(7)) for (int rep_ = 0; rep_ < REPS(7); ++rep_) { pg8::Gemm g{XN, (const bf16*)(ws + WS_W013), M, 2 * FF, D}; pg8::StaticOrder S; S.init(M, 2 * FF, c.nb, c.bid); pg8::EpiSwiglu E{(bf16*)(ws + WS_H), FF};
        pg8::gemm_phase<pg8::EpiSwiglu, pg8::StaticOrder, true, true>(c.lds, g, S, E); } SEAM(7);
    if (IN(8)) for (int rep_ = 0; rep_ < REPS(8); ++rep_) { pg8::Gemm g{(const bf16*)(ws + WS_H), (const bf16*)(ws + WS_W02), M, D, FF}; pg8::StaticOrder S; S.init(M, D, c.nb, c.bid); pg8::EpiResid E{p.out, p.out, D};
        pg8::gemm_phase<pg8::EpiResid, pg8::StaticOrder, true, true>(c.lds, g, S, E); } SEAM(8);
    if (IN(9)) for (int rep_ = 0; rep_ < REPS(9); ++rep_) { phase_rms<true>(p.out, p.in[I_O_NORM_MIX], XN, c); } SEAM(9);
    if (IN(10)) for (int rep_ = 0; rep_ < REPS(10); ++rep_) { pg8::Gemm g{XN, (const bf16*)(ws + WS_W1IN), M, 4096, D / 2, SC_ONE, SC_W}; pg8::StaticOrder S; S.init(M, 4096, c.nb, c.bid); pg8::EpiL1In E{(bf16*)(ws + WS_QKV), (bf16*)(ws + WS_U)};
        pg8::gemm_phase<pg8::EpiL1In, pg8::StaticOrder, true, true, true>(c.lds, g, S, E); } SEAM(10);
    if (IN(11)) for (int rep_ = 0; rep_ < REPS(11); ++rep_) { phase_attn(p, c); phase_s5(p, c); } SEAM(11);
    if (IN(12)) for (int rep_ = 0; rep_ < REPS(12); ++rep_) { pg8::Gemm g{(const bf16*)(ws + WS_Y), (const bf16*)(ws + WS_WGLU), M, 1024, 1024}; pg8::StaticOrder S; S.init(M, 1024, c.nb, c.bid);
        pg8::EpiGluGate E{(const bf16*)(ws + WS_Y), p.in[I_O_B_GLU], MIX, 2048, 1024};
        pg8::gemm_phase<pg8::EpiGluGate, pg8::StaticOrder, true, true>(c.lds, g, S, E); phase_attn_merge(p, c); } SEAM(12);
    if (IN(13)) for (int rep_ = 0; rep_ < REPS(13); ++rep_) { pg8::Gemm g{MIX, (const bf16*)(ws + WS_W1OUT), M, D, D}; pg8::StaticOrder S; S.init(M, D, c.nb, c.bid); pg8::EpiResid E{p.out, p.out, D};
        pg8::gemm_phase<pg8::EpiResid, pg8::StaticOrder, true, true>(c.lds, g, S, E); } SEAM(13);
    if (IN(14)) for (int rep_ = 0; rep_ < REPS(14); ++rep_) { phase_route(p, c); } SEAM(14);
    if (IN(15)) for (int rep_ = 0; rep_ < REPS(15); ++rep_) { phase_assign(p, c); } SEAM(15);
    if (IN(16)) for (int rep_ = 0; rep_ < REPS(16); ++rep_) { const int nt = TILEE[255]; pg8::Gemm g{(const bf16*)(ws + WS_XG), (const bf16*)(ws + WS_WE13), nt * 256, 2 * FF, D / 2, SC_ONE, SC_W};
        pg8::MoeOrder S; S.init(nt * 256, 2 * FF, c.nb, c.bid); S.tile_e = TILEE; S.estride = (size_t)2 * FF * D; pg8::EpiSwiglu8 E{(ws + WS_HG), FF};
        pg8::gemm_phase<pg8::EpiSwiglu8, pg8::MoeOrder, true, true, true>(c.lds, g, S, E); } SEAM(16);
    if (IN(17)) for (int rep_ = 0; rep_ < REPS(17); ++rep_) { const int nt = TILEE[255]; pg8::Gemm g{(const bf16*)(ws + WS_HG), (const bf16*)(ws + WS_WE2), nt * 256, D, FF / 2, SC_H, SC_W};
        pg8::MoeOrder S; S.init(nt * 256, D, c.nb, c.bid); S.tile_e = TILEE; S.estride = (size_t)D * FF; pg8::EpiPlain E{(bf16*)(ws + WS_XG), D};
        pg8::gemm_phase<pg8::EpiPlain, pg8::MoeOrder, true, true, true>(c.lds, g, S, E); } SEAM(17);
    if (IN(18)) for (int rep_ = 0; rep_ < REPS(18); ++rep_) { phase_final(p, c); }
#undef IN
#undef SEAM
}

extern "C" void kernel_launch(void* const* d_in, const int* in_sizes, int n_in, void* d_out, int out_size, void* d_ws, size_t ws_size, hipStream_t stream) {
    static int grid = 0;
    if (grid == 0) {
        if (n_in != N_IN || out_size != M * D || ws_size < WS_END) { fprintf(stderr, "kernel_launch: unexpected shapes (n_in %d out %d ws %zu need %zu)\n", n_in, out_size, ws_size, (size_t)WS_END); grid = -1; return; }
        int dev = 0, cus = 0;
        if (hipGetDevice(&dev) != hipSuccess || hipDeviceGetAttribute(&cus, hipDeviceAttributeMultiprocessorCount, dev) != hipSuccess) { grid = -1; return; }
        if (hipFuncSetAttribute((const void*)mega, hipFuncAttributeMaxDynamicSharedMemorySize, LDS_BYTES) != hipSuccess) { fprintf(stderr, "kernel_launch: hipFuncSetAttribute failed\n"); grid = -1; return; }
        int per_cu = 0; (void)hipOccupancyMaxActiveBlocksPerMultiprocessor(&per_cu, (const void*)mega, NTHR, LDS_BYTES); (void)hipGetLastError();
        if (per_cu < 1) fprintf(stderr, "kernel_launch: occupancy query reports %d blocks per CU\n", per_cu);
        grid = cus;
    }
    if (grid < 0) return;
    (void)hipMemsetAsync((char*)d_ws + WS_CTL, 0, CTL_BYTES, stream);
    Params p{};
    for (int i = 0; i < N_IN; ++i) p.in[i] = (const float*)d_in[i];
    p.out = (float*)d_out; p.ws = (unsigned char*)d_ws;
#ifndef MK_FUSED
#define MK_FUSED 1
#endif
    if (MK_FUSED) { p.lo = 0; p.hi = NPHASE; hipLaunchKernelGGL(mega, dim3(grid), dim3(NTHR), LDS_BYTES, stream, p); }
    else for (int k = 0; k < NPHASE; ++k) { p.lo = k; p.hi = k + 1; hipLaunchKernelGGL(mega, dim3(grid), dim3(NTHR), LDS_BYTES, stream, p); }
}
```

```cpp
#include <hip/hip_runtime.h>
#include <cstdio>
#include <cstdint>
namespace pg8 {
#define PG8_LAS __attribute__((address_space(3)))
typedef unsigned short bf16_t;
typedef short bf16x8 __attribute__((ext_vector_type(8)));
typedef float f32x4 __attribute__((ext_vector_type(4)));
typedef unsigned u32x4 __attribute__((ext_vector_type(4)));
constexpr int BM = 256, BK = 64, HALF = 128, HTB = HALF * BK * 2  , STAGE_BYTES = 8 * HTB, NXCD = 8, WGM = 4;

__host__ __device__ __forceinline__ int lds_byte(int r, int c) { const int st = (r >> 4) * 2 + (c >> 5), rr = r & 15, cc = c & 31, ob = rr * 64 + cc * 2; return st * 1024 + (ob ^ (((ob >> 9) & 1) << 5)); }
__host__ __device__ __forceinline__ void stage_rc(int b, int& R, int& C) { const int st = b / 1024, sb = b % 1024, swz = sb ^ (((sb >> 9) & 1) << 5); R = (st >> 1) * 16 + swz / 64; C = (st & 1) * 32 + (swz % 64) / 2; }
__host__ __device__ __forceinline__ int perm32(int rho) { const int n = rho >> 4, i = rho & 15; return 8 * (i >> 2) + 4 * n + (i & 3); }

struct Unit { int pm, pn; };
struct Gemm { const bf16_t* A; const bf16_t* Bt; int M, N, K; int sa, sb; };
typedef int i32x8 __attribute__((ext_vector_type(8)));
typedef int i32x4v __attribute__((ext_vector_type(4)));
__device__ __forceinline__ void mfma8(f32x4& acc, i32x8 a, i32x8 b, int sa_, int sb_) { asm volatile("v_mfma_scale_f32_16x16x128_f8f6f4 %0, %1, %2, %0, %3, %4 op_sel_hi:[0,0,0]" : "+v"(acc) : "v"(a), "v"(b), "v"(sa_), "v"(sb_)); }
__device__ __forceinline__ i32x8 cat8(bf16x8 a, bf16x8 b) { return __builtin_shufflevector(__builtin_bit_cast(i32x4v, a), __builtin_bit_cast(i32x4v, b), 0, 1, 2, 3, 4, 5, 6, 7); }

struct StaticOrder {
    int nM, nN, nwg, G, c;
    __host__ __device__ void init(int M, int N, int G_, int c_) { nM = M / BM; nN = N / BM; nwg = nM * nN; G = G_; c = c_; }
    __host__ __device__ bool next(int i, Unit& u) const {
        const long L = (long)i * G + c; if (L >= nwg) return false;
        int wgid = (int)L; { const int q = nwg / NXCD, r = nwg % NXCD, xcd = wgid % NXCD, off = wgid / NXCD; wgid = (xcd < r ? xcd * (q + 1) : r * (q + 1) + (xcd - r) * q) + off; }
        const int nig = WGM * nN, gid = wgid / nig, fm = gid * WGM, gsz = (nM - fm) < WGM ? (nM - fm) : WGM;
        u.pm = fm + ((wgid % nig) % gsz); u.pn = (wgid % nig) / gsz; return true;
    }
    __device__ __forceinline__ size_t bbase(const Unit&) const { return 0; }
    __device__ __forceinline__ void a_ready(const Unit&) const {}
    __device__ __forceinline__ void done(const Unit&) const {}
};
__device__ __forceinline__ unsigned cvt_pk_bf16(float lo, float hi) { unsigned r; asm volatile("v_cvt_pk_bf16_f32 %0, %1, %2" : "=v"(r) : "v"(lo), "v"(hi)); return r; }
__device__ __forceinline__ float sigm(float x) { return __builtin_amdgcn_rcpf(1.0f + __expf(-x)); }
typedef float f32x2p __attribute__((ext_vector_type(2)));
__device__ __forceinline__ f32x2p swiglu2(f32x2p a, f32x2p b, float inv_s) {
    const f32x2p t = a * (f32x2p){-1.4426950408889634f, -1.4426950408889634f};
    f32x2p e; e.x = __builtin_amdgcn_exp2f(t.x); e.y = __builtin_amdgcn_exp2f(t.y);
    const f32x2p d = e * (f32x2p){inv_s, inv_s} + (f32x2p){inv_s, inv_s};
    f32x2p r; r.x = __builtin_amdgcn_rcpf(d.x); r.y = __builtin_amdgcn_rcpf(d.y);
    return (a * b) * r;
}
__device__ __forceinline__ f32x2p glu2(f32x2p v, f32x2p g) {
    const f32x2p t = g * (f32x2p){-1.4426950408889634f, -1.4426950408889634f};
    f32x2p e; e.x = __builtin_amdgcn_exp2f(t.x); e.y = __builtin_amdgcn_exp2f(t.y);
    const f32x2p d = e + (f32x2p){1.0f, 1.0f};
    f32x2p r; r.x = __builtin_amdgcn_rcpf(d.x); r.y = __builtin_amdgcn_rcpf(d.y);
    return v * r;
}
__device__ __forceinline__ f32x4 glu4(const f32x4& v, const f32x4& g) {
    const f32x2p lo = glu2((f32x2p){v[0], v[1]}, (f32x2p){g[0], g[1]}), hi = glu2((f32x2p){v[2], v[3]}, (f32x2p){g[2], g[3]});
    return (f32x4){lo.x, lo.y, hi.x, hi.y};
}
__device__ __forceinline__ f32x4 swiglu4(const f32x4& a, const f32x4& b, float inv_s) {
    const f32x2p lo = swiglu2((f32x2p){a[0], a[1]}, (f32x2p){b[0], b[1]}, inv_s), hi = swiglu2((f32x2p){a[2], a[3]}, (f32x2p){b[2], b[3]}, inv_s);
    return (f32x4){lo.x, lo.y, hi.x, hi.y};
}
__device__ __forceinline__ u32x4 pack8(const f32x4& v0, const f32x4& v1) { u32x4 w; w.x = cvt_pk_bf16(v0[0], v0[1]); w.y = cvt_pk_bf16(v0[2], v0[3]); w.z = cvt_pk_bf16(v1[0], v1[1]); w.w = cvt_pk_bf16(v1[2], v1[3]); return w; }
__device__ __forceinline__ float bfl(unsigned w) { return __uint_as_float(w << 16); }
__device__ __forceinline__ float bfh(unsigned w) { return __uint_as_float(w & 0xffff0000u); }

struct EpiL0In {
    static constexpr bool PERM = true, AFTER_DRAIN = false;
    bf16_t* GLU; bf16_t* Z; int zoff;
    __device__ __forceinline__ void operator()(const f32x4 (&acc)[2][2][4][2], const Unit& u, int wr, int wc, int fr, int fq) const {
        const int row0 = u.pm * BM + wr * 64 + fr;
        if (u.pn < 8) {
            const int col0 = u.pn * 128 + wc * 32 + 8 * fq;
#pragma unroll
            for (int ai = 0; ai < 2; ++ai)
#pragma unroll
                for (int m = 0; m < 4; ++m) { bf16_t* rowp = GLU + (size_t)(row0 + ai * HALF + m * 16) * 1024 + col0; f32x4 v0, v1;
                    v0 = glu4(acc[ai][0][m][0], acc[ai][1][m][0]); v1 = glu4(acc[ai][0][m][1], acc[ai][1][m][1]);
                    *(u32x4*)rowp = pack8(v0, v1); }
        } else {
            const int col0 = zoff + (u.pn - 8) * BM + wc * 32 + 8 * fq;
#pragma unroll
            for (int ai = 0; ai < 2; ++ai)
#pragma unroll
                for (int m = 0; m < 4; ++m) { bf16_t* rowp = Z + (size_t)(row0 + ai * HALF + m * 16) * 4096 + col0;
#pragma unroll
                    for (int bj = 0; bj < 2; ++bj) *(u32x4*)(rowp + bj * HALF) = pack8(acc[ai][bj][m][0], acc[ai][bj][m][1]); }
        }
    }
};
struct EpiSwiglu {
    static constexpr bool PERM = true, AFTER_DRAIN = false;
    bf16_t* O; int ldc;
    __device__ __forceinline__ void operator()(const f32x4 (&acc)[2][2][4][2], const Unit& u, int wr, int wc, int fr, int fq) const {
        const int row0 = u.pm * BM + wr * 64 + fr, col0 = u.pn * 128 + wc * 32 + 8 * fq;
#pragma unroll
        for (int ai = 0; ai < 2; ++ai)
#pragma unroll
            for (int m = 0; m < 4; ++m) { bf16_t* rowp = O + (size_t)(row0 + ai * HALF + m * 16) * ldc + col0; f32x4 v0, v1;
                v0 = swiglu4(acc[ai][0][m][0], acc[ai][1][m][0], 1.0f); v1 = swiglu4(acc[ai][0][m][1], acc[ai][1][m][1], 1.0f);
                *(u32x4*)rowp = pack8(v0, v1); }
    }
};
__device__ __forceinline__ float clamp448(float x) { return __builtin_fminf(__builtin_fmaxf(x, -448.0f), 448.0f); }
__device__ __forceinline__ unsigned pk4_fp8(float a, float b, float c, float d) { unsigned w = 0u; w = __builtin_amdgcn_cvt_pk_fp8_f32(clamp448(a), clamp448(b), w, false); w = __builtin_amdgcn_cvt_pk_fp8_f32(clamp448(c), clamp448(d), w, true); return w; }
struct EpiSwiglu8 {
    static constexpr bool PERM = true, AFTER_DRAIN = false;
    unsigned char* O; int ldc;
    __device__ __forceinline__ void operator()(const f32x4 (&acc)[2][2][4][2], const Unit& u, int wr, int wc, int fr, int fq) const {
        const int row0 = u.pm * BM + wr * 64 + fr, col0 = u.pn * 128 + wc * 32 + 8 * fq;
#pragma unroll
        for (int ai = 0; ai < 2; ++ai)
#pragma unroll
            for (int m = 0; m < 4; ++m) { unsigned char* rowp = O + (size_t)(row0 + ai * HALF + m * 16) * ldc + col0; f32x4 v0, v1;
                v0 = swiglu4(acc[ai][0][m][0], acc[ai][1][m][0], 0.125f); v1 = swiglu4(acc[ai][0][m][1], acc[ai][1][m][1], 0.125f);
                typedef unsigned u32x2e __attribute__((ext_vector_type(2))); u32x2e w; w.x = pk4_fp8(v0[0], v0[1], v0[2], v0[3]); w.y = pk4_fp8(v1[0], v1[1], v1[2], v1[3]); *(u32x2e*)rowp = w; }
    }
};
struct EpiResid {
    static constexpr bool PERM = false, AFTER_DRAIN = false;
    const float* res; float* out; int ldc;
    __device__ __forceinline__ void operator()(const f32x4 (&acc)[2][2][4][2], const Unit& u, int wr, int wc, int fr, int fq) const {
        const int row0 = u.pm * BM + wr * 64 + fr, col0 = u.pn * BM + wc * 32 + 4 * fq;
#pragma unroll
        for (int ai = 0; ai < 2; ++ai) { f32x4 r[4][2][2];
#pragma unroll
            for (int m = 0; m < 4; ++m) { const size_t off = (size_t)(row0 + ai * HALF + m * 16) * ldc + col0;
#pragma unroll
                for (int bj = 0; bj < 2; ++bj)
#pragma unroll
                    for (int n = 0; n < 2; ++n) r[m][bj][n] = *(const f32x4*)(res + off + bj * HALF + n * 16); }
#pragma unroll
            for (int m = 0; m < 4; ++m) { const size_t off = (size_t)(row0 + ai * HALF + m * 16) * ldc + col0;
#pragma unroll
                for (int bj = 0; bj < 2; ++bj)
#pragma unroll
                    for (int n = 0; n < 2; ++n) *(f32x4*)(out + off + bj * HALF + n * 16) = r[m][bj][n] + acc[ai][bj][m][n]; } }
    }
};
struct EpiL1In {
    static constexpr bool PERM = true, AFTER_DRAIN = false;
    bf16_t* QKV; bf16_t* U;
    __device__ __forceinline__ void operator()(const f32x4 (&acc)[2][2][4][2], const Unit& u, int wr, int wc, int fr, int fq) const {
        const int row0 = u.pm * BM + wr * 64 + fr; const bool isu = u.pn >= 12;
        bf16_t* base = isu ? U : QKV; const int ldc = isu ? 1024 : 3072; const int col0 = (isu ? u.pn - 12 : u.pn) * BM + wc * 32 + 8 * fq;
        const float sc = u.pn < 4 ? 0.08838834764831845f : 1.0f;
#pragma unroll
        for (int ai = 0; ai < 2; ++ai)
#pragma unroll
            for (int m = 0; m < 4; ++m) { bf16_t* rowp = base + (size_t)(row0 + ai * HALF + m * 16) * ldc + col0;
#pragma unroll
                for (int bj = 0; bj < 2; ++bj) *(u32x4*)(rowp + bj * HALF) = pack8(acc[ai][bj][m][0] * sc, acc[ai][bj][m][1] * sc); }
    }
};
struct EpiGluGate {
    static constexpr bool PERM = true, AFTER_DRAIN = false;
    const bf16_t* Y; const float* bias; bf16_t* O; int ldo, ooff;
    __device__ __forceinline__ void operator()(const f32x4 (&acc)[2][2][4][2], const Unit& u, int wr, int wc, int fr, int fq) const {
        const int row0 = u.pm * BM + wr * 64 + fr, col0 = u.pn * BM + wc * 32 + 8 * fq;
        f32x4 bb[2][2];
#pragma unroll
        for (int bj = 0; bj < 2; ++bj) { bb[bj][0] = *(const f32x4*)(bias + col0 + bj * HALF); bb[bj][1] = *(const f32x4*)(bias + col0 + bj * HALF + 4); }
#pragma unroll
        for (int ai = 0; ai < 2; ++ai) { u32x4 yw[4][2];
#pragma unroll
            for (int m = 0; m < 4; ++m)
#pragma unroll
                for (int bj = 0; bj < 2; ++bj) yw[m][bj] = *(const u32x4*)(Y + (size_t)(row0 + ai * HALF + m * 16) * 1024 + col0 + bj * HALF);
#pragma unroll
            for (int m = 0; m < 4; ++m) { const size_t r = (size_t)(row0 + ai * HALF + m * 16);
#pragma unroll
                for (int bj = 0; bj < 2; ++bj) { const int c = col0 + bj * HALF; const u32x4 y = yw[m][bj];
                    const f32x4 a0 = acc[ai][bj][m][0] + bb[bj][0], a1 = acc[ai][bj][m][1] + bb[bj][1]; f32x4 v0, v1;
                    v0 = glu4((f32x4){bfl(y.x), bfh(y.x), bfl(y.y), bfh(y.y)}, a0); v1 = glu4((f32x4){bfl(y.z), bfh(y.z), bfl(y.w), bfh(y.w)}, a1);
                    *(u32x4*)(O + r * ldo + ooff + c) = pack8(v0, v1); } } }
    }
};
struct EpiPlain {
    static constexpr bool PERM = true, AFTER_DRAIN = false;
    bf16_t* O; int ldc;
    __device__ __forceinline__ void operator()(const f32x4 (&acc)[2][2][4][2], const Unit& u, int wr, int wc, int fr, int fq) const {
        const int row0 = u.pm * BM + wr * 64 + fr, col0 = u.pn * BM + wc * 32 + 8 * fq;
#pragma unroll
        for (int ai = 0; ai < 2; ++ai)
#pragma unroll
            for (int m = 0; m < 4; ++m) { bf16_t* rowp = O + (size_t)(row0 + ai * HALF + m * 16) * ldc + col0;
#pragma unroll
                for (int bj = 0; bj < 2; ++bj) *(u32x4*)(rowp + bj * HALF) = pack8(acc[ai][bj][m][0], acc[ai][bj][m][1]); }
    }
};
struct MoeOrder : StaticOrder {
    const int* tile_e; size_t estride;
    __device__ __forceinline__ size_t bbase(const Unit& u) const { return (size_t)tile_e[u.pm] * estride; }
};
template <class Epi, class Sched, bool ALIGN_EPI = false, bool SP2 = false, bool F8 = false>
__device__ __forceinline__ void gemm_phase(PG8_LAS unsigned char* lds, const Gemm g, const Sched& S, const Epi& E) {
    const int tid = threadIdx.x, wid = __builtin_amdgcn_readfirstlane(tid >> 6), lane = tid & 63, wr = wid >> 2, wc = wid & 3, fr = lane & 15, fq = lane >> 4;
    const int K = g.K, nt = K / BK;
    unsigned voffA[2], voffB[2];
#pragma unroll
    for (int i = 0; i < 2; ++i) { int R, C; stage_rc(tid * 16 + i * 8192, R, C); const int Rb = Epi::PERM ? ((R & ~31) + perm32(R & 31)) : R;
        voffA[i] = (unsigned)(R * K + C) * 2u; voffB[i] = (unsigned)(tid * 16 + i * 8192); (void)Rb; }
    const size_t kstep = (size_t)(BK * 2);
    const size_t hstep = (size_t)HALF * K * 2;
    const size_t tstep = 2 * hstep;
    const size_t kstepB = (size_t)2 * HTB, hstepB = (size_t)HTB, tstepB = (size_t)nt * 2 * HTB;
    const unsigned ldsw = (unsigned)wid * 1024u;
    const int aoff = lds_byte(wr * 64 + fr, fq * 8), boff = lds_byte(wc * 32 + fr, fq * 8);
#define PG8_SA(b, h) (((b) * 2 + (h)) * HTB)
#define PG8_SB(b, h) ((4 + (b) * 2 + (h)) * HTB)
#define PG8_STAGE(bufoff, gbase, voff) do { _Pragma("unroll") for (int _i = 0; _i < 2; ++_i) \
        __builtin_amdgcn_global_load_lds((const unsigned*)((const char*)(gbase) + (voff)[_i]), (PG8_LAS unsigned*)(lds + (bufoff) + ldsw + _i * 8192), 16, 0, 0); } while (0)
#define PG8_LDA(dst, b, h) do { _Pragma("unroll") for (int m = 0; m < 4; ++m) _Pragma("unroll") for (int k = 0; k < 2; ++k) dst[m][k] = *(const PG8_LAS bf16x8*)(lds + PG8_SA(b, h) + aoff + m * 2048 + k * 1024); } while (0)
#define PG8_LDB(dst, b, h) do { _Pragma("unroll") for (int n = 0; n < 2; ++n) _Pragma("unroll") for (int k = 0; k < 2; ++k) dst[n][k] = *(const PG8_LAS bf16x8*)(lds + PG8_SB(b, h) + boff + n * 2048 + k * 1024); } while (0)
#define PG8_MMA(ai, bj, At, Bt) do { __builtin_amdgcn_s_setprio(1); if constexpr (F8) { _Pragma("unroll") for (int m = 0; m < 4; ++m) _Pragma("unroll") for (int n = 0; n < 2; ++n) \
        mfma8(acc[ai][bj][m][n], cat8(Bt[n][0], Bt[n][1]), cat8(At[m][0], At[m][1]), g.sb, g.sa); } else { \
        _Pragma("unroll") for (int m = 0; m < 4; ++m) _Pragma("unroll") for (int n = 0; n < 2; ++n) _Pragma("unroll") for (int k = 0; k < 2; ++k) \
        acc[ai][bj][m][n] = __builtin_amdgcn_mfma_f32_16x16x32_bf16(Bt[n][k], At[m][k], acc[ai][bj][m][n], 0, 0, 0); } __builtin_amdgcn_s_setprio(0); } while (0)
#define PG8_WAIT_V(n) asm volatile("s_waitcnt vmcnt(" #n ")" ::: "memory")
#define PG8_WAIT_L(n) asm volatile("s_waitcnt lgkmcnt(" #n ")" ::: "memory")
#define PG8_BAR __builtin_amdgcn_s_barrier()
#define PG8_SCHED __builtin_amdgcn_sched_barrier(0)
    Unit cur, nxt; int ui = 0;
    if (!S.next(0, cur)) return;
    f32x4 acc[2][2][4][2];
#pragma unroll
    for (int a = 0; a < 2; ++a)
#pragma unroll
        for (int b = 0; b < 2; ++b)
#pragma unroll
            for (int m = 0; m < 4; ++m)
#pragma unroll
                for (int n = 0; n < 2; ++n) acc[a][b][m][n] = (f32x4){0.f, 0.f, 0.f, 0.f};
    bf16x8 At[4][2], B0[2][2], B1[2][2];
    const char* cA = (const char*)g.A + (size_t)cur.pm * tstep; const char* cB = (const char*)g.Bt + S.bbase(cur) + (size_t)cur.pn * tstepB;
    S.a_ready(cur);
    if constexpr (SP2) {
        PG8_STAGE(PG8_SB(0, 0), cB, voffB); PG8_STAGE(PG8_SB(0, 1), cB + hstepB, voffB); PG8_STAGE(PG8_SA(0, 0), cA, voffA); PG8_STAGE(PG8_SA(0, 1), cA + hstep, voffA);
        if (wr == 1) PG8_BAR;
        PG8_WAIT_V(2); PG8_BAR;
        PG8_STAGE(PG8_SB(1, 0), cB + kstepB, voffB); PG8_STAGE(PG8_SA(1, 0), cA + kstep, voffA); PG8_STAGE(PG8_SB(1, 1), cB + hstepB + kstepB, voffB);
        PG8_WAIT_V(6); PG8_BAR;
    } else {
        PG8_STAGE(PG8_SB(0, 0), cB, voffB); PG8_STAGE(PG8_SA(0, 0), cA, voffA); PG8_STAGE(PG8_SB(0, 1), cB + hstepB, voffB); PG8_STAGE(PG8_SA(0, 1), cA + hstep, voffA);
        if (wr == 1) PG8_BAR;
        PG8_WAIT_V(4); PG8_BAR;
        PG8_STAGE(PG8_SB(1, 0), cB + kstepB, voffB); PG8_STAGE(PG8_SA(1, 0), cA + kstep, voffA); PG8_STAGE(PG8_SB(1, 1), cB + hstepB + kstepB, voffB);
        PG8_WAIT_V(6); PG8_BAR;
    }
    for (;;) {
        const bool has_next = S.next(ui + 1, nxt);
        const char* nA = has_next ? (const char*)g.A + (size_t)nxt.pm * tstep : cA; const char* nB = has_next ? (const char*)g.Bt + S.bbase(nxt) + (size_t)nxt.pn * tstepB : cB;
        for (int t = 0; t < nt; t += 2) {
            const bool last = (t == nt - 2);
            const char* a1 = cA + (size_t)(t + 1) * kstep;
            const char* a2 = last ? nA : cA + (size_t)(t + 2) * kstep; const char* b2 = last ? nB : cB + (size_t)(t + 2) * kstepB;
            const char* a3 = a2 + kstep; const char* b3 = b2 + kstepB;
            if (last && has_next) S.a_ready(nxt);
            if constexpr (SP2) {
            PG8_LDB(B0, 0, 0); PG8_LDB(B1, 0, 1); PG8_SCHED; PG8_LDA(At, 0, 0); PG8_STAGE(PG8_SA(1, 1), a1 + hstep, voffA);
            PG8_WAIT_V(8); PG8_WAIT_L(0); PG8_BAR; PG8_MMA(0, 0, At, B0); PG8_MMA(0, 1, At, B1); PG8_BAR; PG8_SCHED;
            PG8_LDA(At, 0, 1); PG8_STAGE(PG8_SB(0, 0), b2, voffB); PG8_STAGE(PG8_SB(0, 1), b2 + hstepB, voffB); PG8_STAGE(PG8_SA(0, 0), a2, voffA);
            PG8_WAIT_V(8); PG8_WAIT_L(0); PG8_BAR; PG8_MMA(1, 0, At, B0); PG8_MMA(1, 1, At, B1); PG8_BAR; PG8_SCHED;
            PG8_LDB(B0, 1, 0); PG8_LDB(B1, 1, 1); PG8_SCHED; PG8_LDA(At, 1, 0); PG8_STAGE(PG8_SA(0, 1), a2 + hstep, voffA);
            PG8_WAIT_V(8); PG8_WAIT_L(0); PG8_BAR; PG8_MMA(0, 0, At, B0); PG8_MMA(0, 1, At, B1); PG8_BAR; PG8_SCHED;
            PG8_LDA(At, 1, 1); PG8_STAGE(PG8_SB(1, 0), b3, voffB); PG8_STAGE(PG8_SB(1, 1), b3 + hstepB, voffB); PG8_STAGE(PG8_SA(1, 0), a3, voffA);
            PG8_WAIT_V(8); PG8_WAIT_L(0); PG8_BAR; PG8_MMA(1, 0, At, B0); PG8_MMA(1, 1, At, B1); PG8_BAR; PG8_SCHED;
            } else {
            PG8_LDB(B0, 0, 0); PG8_SCHED; PG8_LDA(At, 0, 0); PG8_STAGE(PG8_SA(1, 1), a1 + hstep, voffA);
            PG8_WAIT_L(8); PG8_BAR; PG8_WAIT_L(0); PG8_MMA(0, 0, At, B0); PG8_BAR; PG8_SCHED;
            PG8_LDB(B1, 0, 1); PG8_STAGE(PG8_SB(0, 0), b2, voffB);
            PG8_BAR; PG8_WAIT_L(0); PG8_MMA(0, 1, At, B1); PG8_BAR;
            PG8_LDA(At, 0, 1); PG8_STAGE(PG8_SA(0, 0), a2, voffA);
            PG8_BAR; PG8_WAIT_L(0); PG8_MMA(1, 0, At, B0); PG8_BAR; PG8_SCHED;
            PG8_STAGE(PG8_SB(0, 1), b2 + hstepB, voffB);
            PG8_WAIT_V(6); PG8_BAR; PG8_MMA(1, 1, At, B1); PG8_BAR;
            PG8_LDB(B0, 1, 0); PG8_SCHED; PG8_LDA(At, 1, 0); PG8_STAGE(PG8_SA(0, 1), a2 + hstep, voffA);
            PG8_WAIT_L(8); PG8_BAR; PG8_WAIT_L(0); PG8_MMA(0, 0, At, B0); PG8_BAR; PG8_SCHED;
            PG8_LDB(B1, 1, 1); PG8_STAGE(PG8_SB(1, 0), b3, voffB);
            PG8_BAR; PG8_WAIT_L(0); PG8_MMA(0, 1, At, B1); PG8_BAR;
            PG8_LDA(At, 1, 1); PG8_STAGE(PG8_SA(1, 0), a3, voffA);
            PG8_BAR; PG8_WAIT_L(0); PG8_MMA(1, 0, At, B0); PG8_BAR; PG8_SCHED;
            PG8_STAGE(PG8_SB(1, 1), b3 + hstepB, voffB);
            PG8_WAIT_V(6); PG8_BAR; PG8_MMA(1, 1, At, B1); PG8_BAR;
            }
        }
        if constexpr (ALIGN_EPI) { if (wr == 0) PG8_BAR; }
        if constexpr (F8) { asm volatile("s_nop 15\n\ts_nop 15" ::: "memory"); }
        if constexpr (!Epi::AFTER_DRAIN) { E(acc, cur, wr, wc, fr, fq); S.done(cur); }
        if (!has_next) break;
#pragma unroll
        for (int a = 0; a < 2; ++a)
#pragma unroll
            for (int b = 0; b < 2; ++b)
#pragma unroll
                for (int m = 0; m < 4; ++m)
#pragma unroll
                    for (int n = 0; n < 2; ++n) acc[a][b][m][n] = (f32x4){0.f, 0.f, 0.f, 0.f};
        cur = nxt; cA = nA; cB = nB; ++ui;
        if constexpr (ALIGN_EPI) { if (wr == 1) PG8_BAR; }
    }
    PG8_WAIT_V(0);
    if constexpr (!ALIGN_EPI) { if (wr == 0) PG8_BAR; }
    PG8_BAR;
    if constexpr (Epi::AFTER_DRAIN) { E.fused(acc, cur, wr, wc, fr, fq, lds, wid, lane); S.done(cur); }
#undef PG8_SA
#undef PG8_SB
#undef PG8_STAGE
#undef PG8_LDA
#undef PG8_LDB
#undef PG8_MMA
#undef PG8_WAIT_V
#undef PG8_WAIT_L
#undef PG8_BAR
#undef PG8_SCHED
}
}
#define DI __device__ __forceinline__
#define LAS __attribute__((address_space(3)))
typedef unsigned short bf16;
typedef short bf16x8 __attribute__((ext_vector_type(8)));
typedef short s16x4 __attribute__((ext_vector_type(4)));
typedef float f32x4 __attribute__((ext_vector_type(4)));
typedef float f32x2 __attribute__((ext_vector_type(2)));
typedef float f32x16 __attribute__((ext_vector_type(16)));
typedef unsigned u32x4 __attribute__((ext_vector_type(4)));
typedef unsigned u32x2 __attribute__((ext_vector_type(2)));

constexpr int M = 16384, D = 2048, SEQ = 4096, NH = 8, DH = 128, FF = 5632, NE = 8;
constexpr int NWAVES = 8, NTHR = 512;
constexpr float RMS_EPS = 1e-6f, LN_EPS = 1e-5f;

enum { I_X = 0, I_E_NORM_MIX, I_E_W_IN, I_E_CONV_W, I_E_CONV_B, I_E_LN_G, I_E_LN_B, I_E_QKCONV_W, I_E_QKCONV_B, I_E_B_I, I_E_B_F, I_E_W_OUT, I_E_NORM_FFN, I_E_W1, I_E_W3, I_E_W2,
       I_O_NORM_MIX, I_O_W_IN, I_O_LAM_RE, I_O_LAM_IM, I_O_LOG_DT, I_O_B_RE, I_O_B_IM, I_O_C_RE, I_O_C_IM, I_O_D_SKIP, I_O_W_GLU, I_O_B_GLU, I_O_W_OUT, I_O_NORM_FFN, I_O_ROUTER,
       I_O_EW1, I_O_EW3, I_O_EW2, I_FINAL_NORM, N_IN };

constexpr size_t MiB = 1u << 20, KiB = 1u << 10;
constexpr size_t WS_CTL = 0, CTL_BYTES = 1 * MiB;
constexpr size_t WS_GATES = 1 * MiB;
constexpr size_t WS_BCUM = 2 * MiB;
constexpr size_t WS_AVAL = 2 * MiB + 512 * KiB;
constexpr size_t WS_BLAST = 4 * MiB + 128 * KiB, WS_AMAX = WS_BLAST + 4, WS_MPREV = 3 * MiB;
constexpr size_t WS_NLOC = 3 * MiB + 64 * KiB, WS_NPREV = WS_NLOC + 512 * KiB;
constexpr size_t WS_MXL = 4 * MiB + 512 * KiB;
constexpr size_t WS_TOKE = 7 * MiB + 512 * KiB, WS_TOKG = WS_TOKE + 128 * KiB, WS_SLOT = WS_TOKG + 128 * KiB;
constexpr size_t WS_CNT = WS_SLOT + 128 * KiB;
constexpr size_t WS_TILEE = WS_CNT + 32 * KiB;
constexpr size_t WS_W0IN = 8 * MiB, WS_W0OUT = 32 * MiB, WS_W013 = 40 * MiB, WS_W02 = 84 * MiB, WS_W1IN = 106 * MiB, WS_WGLU = 122 * MiB, WS_W1OUT = 124 * MiB, WS_WE13 = 132 * MiB, WS_WE2 = 484 * MiB;
constexpr size_t A0 = 660 * MiB;
constexpr size_t WS_XN = A0, WS_MIX = A0 + 64 * MiB, R0 = A0 + 128 * MiB;
constexpr size_t WS_GLU = R0, WS_Z = R0 + 32 * MiB, WS_QC = R0 + 160 * MiB, WS_KC = R0 + 192 * MiB, WS_CLOC = R0 + 224 * MiB, WS_CPREV = R0 + 288 * MiB;
constexpr size_t WS_H = R0;
constexpr size_t WS_QKV = R0, WS_U = R0 + 96 * MiB, WS_OG = R0 + 128 * MiB, WS_Y = R0 + 224 * MiB;
constexpr size_t WS_HG = A0, WS_XG = A0 + 374 * MiB;
constexpr size_t WS_END = A0 + 510 * MiB;
constexpr int MAXTILES = 136;
constexpr int CW_BAR = 4096;

constexpr int LDS_BYTES = 147456, MISC_OFF = LDS_BYTES - 256;

struct Params { const float* in[N_IN]; float* out; unsigned char* ws; int lo, hi; };

struct Ctx { LAS unsigned char* lds; int tid, lane, wave, bid, nb; };

DI float wave_sum(float v) {
#pragma unroll
    for (int o = 1; o < 64; o <<= 1) v += __shfl_xor(v, o);
    return v;
}
DI float wave_max(float v) {
#pragma unroll
    for (int o = 1; o < 64; o <<= 1) v = fmaxf(v, __shfl_xor(v, o));
    return v;
}
DI unsigned pk2(float lo, float hi) { unsigned r; asm("v_cvt_pk_bf16_f32 %0, %1, %2" : "=v"(r) : "v"(lo), "v"(hi)); return r; }
typedef __bf16 bf16x2_t __attribute__((ext_vector_type(2)));
DI unsigned pk2m(float lo, float hi) { f32x2 v = {lo, hi}; return __builtin_bit_cast(unsigned, __builtin_convertvector(v, bf16x2_t)); }
DI float bfl(unsigned w) { return __uint_as_float(w << 16); }
DI float bfh(unsigned w) { return __uint_as_float(w & 0xffff0000u); }
DI float bf1(bf16 b) { return __uint_as_float(((unsigned)b) << 16); }
DI float sigm(float x) { return __builtin_amdgcn_rcpf(1.0f + __expf(-x)); }
DI float silu(float x) { return x * sigm(x); }
#define LDS_WAIT() asm volatile("s_waitcnt lgkmcnt(0)" ::: "memory")
#define MFMA16(a, b, c) __builtin_amdgcn_mfma_f32_16x16x32_bf16((a), (b), (c), 0, 0, 0)
#define MFMA32(a, b, c) __builtin_amdgcn_mfma_f32_32x32x16_bf16((a), (b), (c), 0, 0, 0)

DI int toff(int row, int ch) { return 256 * row + 16 * (ch ^ (((row & 3) << 2) | ((row >> 2) & 3))); }
DI bf16x8 ldrow(LAS unsigned char* tile, int row, int ch) { return *(const LAS bf16x8*)(tile + toff(row, ch)); }
DI s16x4 ldtr(LAS unsigned char* tile, int R0, int c16, int lane) {
    const int q = (lane & 15) >> 2, p = lane & 3;
    return __builtin_bit_cast(s16x4, __builtin_amdgcn_ds_read_tr16_b64_v4i16((LAS s16x4*)(tile + toff(R0 + q, 2 * c16 + (p >> 1)) + 8 * (p & 1))));
}
DI bf16x8 cat4(s16x4 a, s16x4 b) { bf16x8 r; r[0] = a[0]; r[1] = a[1]; r[2] = a[2]; r[3] = a[3]; r[4] = b[0]; r[5] = b[1]; r[6] = b[2]; r[7] = b[3]; return r; }
DI bf16x8 pack8f(const f32x4& a, const f32x4& b) { u32x4 w; w.x = pk2m(a[0], a[1]); w.y = pk2m(a[2], a[3]); w.z = pk2m(b[0], b[1]); w.w = pk2m(b[2], b[3]); return __builtin_bit_cast(bf16x8, w); }

DI float clamp448(float x) { return fminf(fmaxf(x, -448.0f), 448.0f); }
DI unsigned pk4_fp8(float a, float b, float c, float d) { unsigned w = 0u; w = __builtin_amdgcn_cvt_pk_fp8_f32(clamp448(a), clamp448(b), w, false); w = __builtin_amdgcn_cvt_pk_fp8_f32(clamp448(c), clamp448(d), w, true); return w; }
struct CvItem { const float* W; unsigned char* WT; int ldw, K, k0, n0, drow; bool f8, perm; };
DI size_t bt_off(int nrow, int kc, int ntiles_k, bool perm) {
    const int pn = nrow >> 8, h = (nrow >> 7) & 1, rp = nrow & 127, t = kc >> 6, cc = kc & 63;
    const int p = rp & 31, slot = perm ? ((rp & ~31) + 16 * ((p >> 2) & 1) + 4 * (p >> 3) + (p & 3)) : rp;
    return ((size_t)pn * ntiles_k + t) * (2 * pg8::HTB) + (size_t)h * pg8::HTB + pg8::lds_byte(slot, cc);
}
DI void cv_load(const CvItem& it, int half, int lane, f32x4 (&r)[16]) {
    const int kq = lane >> 4, c4 = (lane & 15) * 4; const float* src = it.W + (size_t)(it.k0 + 64 * half + kq) * it.ldw + it.n0 + c4;
#pragma unroll
    for (int i = 0; i < 16; ++i) r[i] = __builtin_nontemporal_load((const f32x4*)(src + (size_t)(4 * i) * it.ldw));
}
DI void cv_to_lds(const f32x4 (&r)[16], LAS float* scr, int lane) {
    const int kq = lane >> 4, c4 = (lane & 15) * 4;
#pragma unroll
    for (int i = 0; i < 16; ++i) { LAS float* s = scr + (kq + 4 * i) * 65 + c4; s[0] = r[i].x; s[1] = r[i].y; s[2] = r[i].z; s[3] = r[i].w; }
    LDS_WAIT();
}
DI void cv_out_bf16(const CvItem& it, int half, LAS float* scr, int lane) {
    const int c = lane & 7;
#pragma unroll
    for (int j = 0; j < 8; ++j) { const int n = (lane >> 3) + 8 * j; const LAS float* s = scr + (8 * c) * 65 + n;
        u32x4 o; o.x = pk2(s[0 * 65], s[1 * 65]); o.y = pk2(s[2 * 65], s[3 * 65]); o.z = pk2(s[4 * 65], s[5 * 65]); o.w = pk2(s[6 * 65], s[7 * 65]);
        *(u32x4*)(it.WT + bt_off(it.drow + n, it.k0 + 64 * half + 8 * c, it.K / 64, it.perm)) = o; }
    LDS_WAIT();
}
DI void cv_out_f8(const CvItem& it, int half, LAS float* scr, int lane) {
    const int c = lane & 3;
#pragma unroll
    for (int j = 0; j < 4; ++j) { const int n = (lane >> 2) + 16 * j; const LAS float* s = scr + (16 * c) * 65 + n; u32x4 o;
        o.x = pk4_fp8(64.f * s[0 * 65], 64.f * s[1 * 65], 64.f * s[2 * 65], 64.f * s[3 * 65]); o.y = pk4_fp8(64.f * s[4 * 65], 64.f * s[5 * 65], 64.f * s[6 * 65], 64.f * s[7 * 65]);
        o.z = pk4_fp8(64.f * s[8 * 65], 64.f * s[9 * 65], 64.f * s[10 * 65], 64.f * s[11 * 65]); o.w = pk4_fp8(64.f * s[12 * 65], 64.f * s[13 * 65], 64.f * s[14 * 65], 64.f * s[15 * 65]);
        *(u32x4*)(it.WT + bt_off(it.drow + n, (it.k0 + 64 * half + 16 * c) >> 1, it.K / 128, it.perm)) = o; }
    LDS_WAIT();
}
DI int cv_drow(int mode, int n0) {
    if (mode == 0) return n0;
    if (mode == 1) return 256 * (n0 >> 7) + (n0 & 127);
    if (mode == 2) return 256 * (n0 >> 7) + 128 + (n0 & 127);
    if (n0 < 1024) return 256 * (n0 >> 7) + (n0 & 127);
    if (n0 < 2048) { const int n1 = n0 - 1024; return 256 * (n1 >> 7) + 128 + (n1 & 127); }
    return n0;
}
DI void cv_mat(CvItem& o, const float* W, int ldw, int K, int N, unsigned char* WT, int mode, bool f8, int it, bool perm) {
    o.perm = perm;
    const int nblk = N / 64, kb = it / nblk, nb_ = it % nblk; o.W = W; o.WT = WT; o.ldw = ldw; o.K = K; o.k0 = kb * 128; o.n0 = nb_ * 64; o.drow = cv_drow(mode, o.n0); o.f8 = f8;
}
constexpr int CI_IN0A = (D / 128) * (2048 / 64), CI_IN0C = (D / 128) * (4096 / 64), CI_IN0 = CI_IN0A + CI_IN0C, CI_SQ = (D / 128) * (D / 64), CI_UP = (D / 128) * (FF / 64), CI_DN = (FF / 128) * (D / 64), CI_IN1Q = (D / 128) * (3072 / 64), CI_IN1U = (D / 128) * (1024 / 64), CI_IN1 = CI_IN1Q + CI_IN1U, CI_GLU = 8 * 16;
constexpr int CV_NIT = CI_IN0 + CI_SQ + 2 * CI_UP + CI_DN + CI_IN1 + CI_GLU + CI_SQ + NE * (2 * CI_UP + CI_DN);
DI void cv_locate(const Params& p, int it, CvItem& o) {
    unsigned char* ws = p.ws; int r = it;
    if (r < CI_IN0A) { cv_mat(o, p.in[I_E_W_IN], 6160, D, 2048, ws + WS_W0IN, 3, false, r, true); return; } r -= CI_IN0A;
    if (r < CI_IN0C) { cv_mat(o, p.in[I_E_W_IN] + 2048, 6160, D, 4096, ws + WS_W0IN + 12 * MiB, 0, true, r, true); return; } r -= CI_IN0C;
    if (r < CI_SQ) { cv_mat(o, p.in[I_E_W_OUT], D, D, D, ws + WS_W0OUT, 0, false, r, false); return; } r -= CI_SQ;
    if (r < CI_UP) { cv_mat(o, p.in[I_E_W1], FF, D, FF, ws + WS_W013, 1, false, r, true); return; } r -= CI_UP;
    if (r < CI_UP) { cv_mat(o, p.in[I_E_W3], FF, D, FF, ws + WS_W013, 2, false, r, true); return; } r -= CI_UP;
    if (r < CI_DN) { cv_mat(o, p.in[I_E_W2], D, FF, D, ws + WS_W02, 0, true, r, false); return; } r -= CI_DN;
    if (r < CI_IN1) { cv_mat(o, p.in[I_O_W_IN], 4096, D, 4096, ws + WS_W1IN, 0, true, r, true); return; } r -= CI_IN1;
    if (r < CI_GLU) { cv_mat(o, p.in[I_O_W_GLU], 1024, 1024, 1024, ws + WS_WGLU, 0, false, r, true); return; } r -= CI_GLU;
    if (r < CI_SQ) { cv_mat(o, p.in[I_O_W_OUT], D, D, D, ws + WS_W1OUT, 0, false, r, false); return; } r -= CI_SQ;
    const int per_e = 2 * CI_UP + CI_DN, e = r / per_e; r -= e * per_e;
    if (r < CI_UP) { cv_mat(o, p.in[I_O_EW1] + (size_t)e * D * FF, FF, D, FF, ws + WS_WE13 + (size_t)e * 2 * FF * D, 1, true, r, true); return; } r -= CI_UP;
    if (r < CI_UP) { cv_mat(o, p.in[I_O_EW3] + (size_t)e * D * FF, FF, D, FF, ws + WS_WE13 + (size_t)e * 2 * FF * D, 2, true, r, true); return; } r -= CI_UP;
    cv_mat(o, p.in[I_O_EW2] + (size_t)e * FF * D, D, FF, D, ws + WS_WE2 + (size_t)e * D * FF, 0, true, r, true);
}
DI void phase_convert(const Params& p, const Ctx& c) {
    LAS float* scr = (LAS float*)(c.lds + c.wave * 16640);
    const int gw = c.bid * NWAVES + c.wave, NGW = c.nb * NWAVES;
    if (gw >= CV_NIT) return;
    CvItem cur, nxt; f32x4 ra[16], rb[16];
    cv_locate(p, gw, cur); cv_load(cur, 0, c.lane, ra);
    for (int it = gw; it < CV_NIT; it += NGW) {
        const bool has_next = it + NGW < CV_NIT;
        cv_load(cur, 1, c.lane, rb);
        cv_to_lds(ra, scr, c.lane);
        if (cur.f8) cv_out_f8(cur, 0, scr, c.lane); else cv_out_bf16(cur, 0, scr, c.lane);
        if (has_next) { cv_locate(p, it + NGW, nxt); cv_load(nxt, 0, c.lane, ra); }
        cv_to_lds(rb, scr, c.lane);
        if (cur.f8) cv_out_f8(cur, 1, scr, c.lane); else cv_out_bf16(cur, 1, scr, c.lane);
        cur = nxt;
    }
}

DI void rms_ldg(const float* g, int lane, f32x4 (&gg)[8]) {
#pragma unroll
    for (int j = 0; j < 8; ++j) gg[j] = *(const f32x4*)(g + 4 * lane + 256 * j);
}
template <bool F8 = false> DI void rms_row(const float* xrow, const f32x4 (&gg)[8], void* orow_, int lane, f32x4 (&v)[8]) {
    bf16* orow = (bf16*)orow_;
    float s = 0.f;
#pragma unroll
    for (int j = 0; j < 8; ++j) { v[j] = *(const f32x4*)(xrow + 4 * lane + 256 * j); s += (v[j].x * v[j].x + v[j].y * v[j].y) + (v[j].z * v[j].z + v[j].w * v[j].w); }
    const float rstd = rsqrtf(wave_sum(s) * (1.0f / D) + RMS_EPS);
#pragma unroll
    for (int j = 0; j < 8; ++j) { v[j] = v[j] * rstd * gg[j];
        if constexpr (F8) { *(unsigned*)((unsigned char*)orow_ + 4 * lane + 256 * j) = pk4_fp8(v[j].x, v[j].y, v[j].z, v[j].w); }
        else { u32x2 w; w.x = pk2(v[j].x, v[j].y); w.y = pk2(v[j].z, v[j].w); *(u32x2*)(orow + 4 * lane + 256 * j) = w; } }
}
DI void phase_rms2(const float* X, const float* g, bf16* XNb, unsigned char* XN8, const Ctx& c) {
    const int gw = c.bid * NWAVES + c.wave, NGW = c.nb * NWAVES;
    f32x4 gg[8]; rms_ldg(g, c.lane, gg);
    for (int m = gw; m < M; m += NGW) { f32x4 v[8]; rms_row<false>(X + (size_t)m * D, gg, XNb + (size_t)m * D, c.lane, v);
#pragma unroll
        for (int j = 0; j < 8; ++j) *(unsigned*)(XN8 + (size_t)m * D + 4 * c.lane + 256 * j) = pk4_fp8(v[j].x, v[j].y, v[j].z, v[j].w); }
}
template <bool F8> DI void phase_rms(const float* X, const float* g, void* XN, const Ctx& c) {
    const int gw = c.bid * NWAVES + c.wave, NGW = c.nb * NWAVES;
    f32x4 gg[8]; rms_ldg(g, c.lane, gg);
    f32x4 vn[8];
    if (gw < M) {
#pragma unroll
        for (int j = 0; j < 8; ++j) vn[j] = *(const f32x4*)(X + (size_t)gw * D + 4 * c.lane + 256 * j); }
    for (int m = gw; m < M; m += NGW) { f32x4 v[8]; float s = 0.f;
#pragma unroll
        for (int j = 0; j < 8; ++j) { v[j] = vn[j]; s += (v[j].x * v[j].x + v[j].y * v[j].y) + (v[j].z * v[j].z + v[j].w * v[j].w); }
        if (m + NGW < M) {
#pragma unroll
            for (int j = 0; j < 8; ++j) vn[j] = *(const f32x4*)(X + (size_t)(m + NGW) * D + 4 * c.lane + 256 * j); }
        const float rstd = rsqrtf(wave_sum(s) * (1.0f / D) + RMS_EPS);
        unsigned char* orow = (unsigned char*)XN + (size_t)m * D * (F8 ? 1 : 2);
#pragma unroll
        for (int j = 0; j < 8; ++j) { v[j] = v[j] * rstd * gg[j];
            if constexpr (F8) { *(unsigned*)(orow + 4 * c.lane + 256 * j) = pk4_fp8(v[j].x, v[j].y, v[j].z, v[j].w); }
            else { u32x2 w; w.x = pk2(v[j].x, v[j].y); w.y = pk2(v[j].z, v[j].w); *(u32x2*)((bf16*)orow + 4 * c.lane + 256 * j) = w; } } }
}
DI float xreduce16(const float (&a)[16], int lane) {
    float b8[8], c4[4], d2[2];
    const bool h5 = (lane & 32) != 0, h4 = (lane & 16) != 0, h3 = (lane & 8) != 0, h2 = (lane & 4) != 0;
#pragma unroll
    for (int i = 0; i < 8; ++i) { const float send = h5 ? a[i] : a[8 + i], keep = h5 ? a[8 + i] : a[i]; b8[i] = keep + __shfl_xor(send, 32); }
#pragma unroll
    for (int i = 0; i < 4; ++i) { const float send = h4 ? b8[i] : b8[4 + i], keep = h4 ? b8[4 + i] : b8[i]; c4[i] = keep + __shfl_xor(send, 16); }
#pragma unroll
    for (int i = 0; i < 2; ++i) { const float send = h3 ? c4[i] : c4[2 + i], keep = h3 ? c4[2 + i] : c4[i]; d2[i] = keep + __shfl_xor(send, 8); }
    const float send = h2 ? d2[0] : d2[1], keep = h2 ? d2[1] : d2[0]; float e = keep + __shfl_xor(send, 4);
    e += __shfl_xor(e, 2); e += __shfl_xor(e, 1);
    return e;
}
DI float xreduce8(const float (&a)[8], int lane) {
    float c4[4], d2[2];
    const bool h5 = (lane & 32) != 0, h4 = (lane & 16) != 0, h3 = (lane & 8) != 0;
#pragma unroll
    for (int i = 0; i < 4; ++i) { const float send = h5 ? a[i] : a[4 + i], keep = h5 ? a[4 + i] : a[i]; c4[i] = keep + __shfl_xor(send, 32); }
#pragma unroll
    for (int i = 0; i < 2; ++i) { const float send = h4 ? c4[i] : c4[2 + i], keep = h4 ? c4[2 + i] : c4[i]; d2[i] = keep + __shfl_xor(send, 16); }
    const float send = h3 ? d2[0] : d2[1], keep = h3 ? d2[1] : d2[0]; float e = keep + __shfl_xor(send, 8);
    e += __shfl_xor(e, 4); e += __shfl_xor(e, 2); e += __shfl_xor(e, 1);
    return e;
}
DI void phase_rms_gates(const Params& p, const Ctx& c) {
    LAS float* WG = (LAS float*)c.lds;
    const float* W = p.in[I_E_W_IN];
    __syncthreads();
    for (int idx = c.tid; idx < D * 16; idx += NTHR) { const int k = idx >> 4, j = idx & 15; WG[j * D + k] = W[(size_t)k * 6160 + 6144 + j]; }
    __syncthreads();
    const int gw = c.bid * NWAVES + c.wave, NGW = c.nb * NWAVES;
    float* GATES = (float*)(p.ws + WS_GATES); bf16* XN = (bf16*)(p.ws + WS_XN);
    const int gi = (c.lane >> 2) & 15;
    const float bias = gi < 8 ? p.in[I_E_B_I][gi & 7] : p.in[I_E_B_F][gi & 7];
    f32x4 gg[8]; rms_ldg(p.in[I_E_NORM_MIX], c.lane, gg);
    for (int m = gw; m < M; m += 2 * NGW) {
        asm volatile("" ::: "memory");
        const bool two = m + NGW < M; const int m1 = two ? m + NGW : m;
        f32x4 v0[8], v1[8];
        rms_row(p.in[I_X] + (size_t)m * D, gg, XN + (size_t)m * D, c.lane, v0);
        rms_row(p.in[I_X] + (size_t)m1 * D, gg, XN + (size_t)m1 * D, c.lane, v1);
#pragma unroll
        for (int j = 0; j < 8; ++j) { *(unsigned*)(p.ws + WS_MIX + (size_t)m * D + 4 * c.lane + 256 * j) = pk4_fp8(v0[j].x, v0[j].y, v0[j].z, v0[j].w);
            *(unsigned*)(p.ws + WS_MIX + (size_t)m1 * D + 4 * c.lane + 256 * j) = pk4_fp8(v1[j].x, v1[j].y, v1[j].z, v1[j].w); }
        float a0[16], a1[16];
#pragma unroll
        for (int jg = 0; jg < 16; ++jg) { float s0 = 0.f, s1 = 0.f;
#pragma unroll
            for (int j = 0; j < 8; ++j) { const f32x4 w = *(const LAS f32x4*)(WG + jg * D + 4 * c.lane + 256 * j);
                s0 += (v0[j].x * w.x + v0[j].y * w.y) + (v0[j].z * w.z + v0[j].w * w.w); s1 += (v1[j].x * w.x + v1[j].y * w.y) + (v1[j].z * w.z + v1[j].w * w.w); }
            a0[jg] = s0; a1[jg] = s1; }
        const float e0 = xreduce16(a0, c.lane), e1 = xreduce16(a1, c.lane);
        if ((c.lane & 3) == 0) { GATES[(size_t)m * 16 + gi] = e0 + bias; if (two) GATES[(size_t)m1 * 16 + gi] = e1 + bias; }
    }
    __syncthreads();
}

DI void phase_conv31(const Params& p, const Ctx& c) {
    const bf16* GLU = (const bf16*)(p.ws + WS_GLU); bf16* MIX = (bf16*)(p.ws + WS_MIX);
    LAS float* T = (LAS float*)c.lds;
    const int ch = 2 * c.tid;
    float w0[31], w1[31];
#pragma unroll
    for (int j = 0; j < 31; ++j) { const f32x2 w = *(const f32x2*)(p.in[I_E_CONV_W] + j * 1024 + ch); w0[j] = w.x; w1[j] = w.y; }
    const f32x2 bb = *(const f32x2*)(p.in[I_E_CONV_B] + ch);
    for (int tile = c.bid; tile < M / 32; tile += c.nb) {
        const int t0 = tile * 32, tl0 = t0 & (SEQ - 1);
        float x0[62], x1[62];
#pragma unroll
        for (int i = 0; i < 62; ++i) { unsigned w = 0u; if (tl0 - 30 + i >= 0) w = *(const unsigned*)(GLU + (size_t)(t0 - 30 + i) * 1024 + ch); x0[i] = bfl(w); x1[i] = bfh(w); }
        __syncthreads();
#pragma unroll
        for (int tt = 0; tt < 32; ++tt) { float a0 = bb.x, a1 = bb.y;
#pragma unroll
            for (int j = 0; j < 31; ++j) { a0 += w0[j] * x0[tt + j]; a1 += w1[j] * x1[tt + j]; }
            *(LAS f32x2*)(T + tt * 1024 + ch) = (f32x2){a0, a1}; }
        __syncthreads();
        f32x4 lg[4], lb[4];
#pragma unroll
        for (int j = 0; j < 4; ++j) { const int cc = 4 * c.lane + 256 * j; lg[j] = *(const f32x4*)(p.in[I_E_LN_G] + cc); lb[j] = *(const f32x4*)(p.in[I_E_LN_B] + cc); }
#pragma unroll
        for (int i = 0; i < 4; ++i) { const int tt = 4 * c.wave + i; f32x4 v[4]; float s = 0.f;
#pragma unroll
            for (int j = 0; j < 4; ++j) { v[j] = *(const LAS f32x4*)(T + tt * 1024 + 4 * c.lane + 256 * j); s += (v[j].x + v[j].y) + (v[j].z + v[j].w); }
            const float mu = wave_sum(s) * (1.0f / 1024.0f); float q = 0.f;
#pragma unroll
            for (int j = 0; j < 4; ++j) { v[j] = v[j] - mu; q += (v[j].x * v[j].x + v[j].y * v[j].y) + (v[j].z * v[j].z + v[j].w * v[j].w); }
            const float rstd = rsqrtf(wave_sum(q) * (1.0f / 1024.0f) + LN_EPS);
#pragma unroll
            for (int j = 0; j < 4; ++j) { const int cc = 4 * c.lane + 256 * j;
                const f32x4 y = v[j] * rstd * lg[j] + lb[j]; u32x2 w; w.x = pk2(silu(y.x), silu(y.y)); w.y = pk2(silu(y.z), silu(y.w));
                *(u32x2*)(MIX + (size_t)(t0 + tt) * 2048 + cc) = w; } }
    }
    __syncthreads();
}

DI float logsig(float x) { return fminf(x, 0.f) - log1pf(__expf(-fabsf(x))); }
DI void qkconv8(const bf16* Z, size_t grow, int pos, int zc, const float* cw, const float* cb, float (&o)[8]) {
    const f32x4 b0 = *(const f32x4*)(cb + zc), b1 = *(const f32x4*)(cb + zc + 4);
    o[0] = b0.x; o[1] = b0.y; o[2] = b0.z; o[3] = b0.w; o[4] = b1.x; o[5] = b1.y; o[6] = b1.z; o[7] = b1.w;
#pragma unroll
    for (int j = 0; j < 4; ++j) { if (pos - 3 + j >= 0) { const u32x4 x = *(const u32x4*)(Z + (grow - 3 + j) * 4096 + zc);
            const f32x4 w0 = *(const f32x4*)(cw + j * 2048 + zc), w1 = *(const f32x4*)(cw + j * 2048 + zc + 4);
            o[0] += w0.x * bfl(x.x); o[1] += w0.y * bfh(x.x); o[2] += w0.z * bfl(x.y); o[3] += w0.w * bfh(x.y); o[4] += w1.x * bfl(x.z); o[5] += w1.y * bfh(x.z); o[6] += w1.z * bfl(x.w); o[7] += w1.w * bfh(x.w); } }
#pragma unroll
    for (int i = 0; i < 8; ++i) o[i] = silu(o[i]);
}
DI void qk_load4(const bf16* Z, size_t grow, int pos, int zc, u32x4 (&x)[4]) {
#pragma unroll
    for (int j = 0; j < 4; ++j) { x[j] = (u32x4){0u, 0u, 0u, 0u}; if (pos - 3 + j >= 0) x[j] = *(const u32x4*)(Z + (grow - 3 + j) * 4096 + zc); }
}
DI void qk_ldw(int zc, const float* cw, const float* cb, f32x4 (&wt)[5][2]) {
#pragma unroll
    for (int j = 0; j < 4; ++j) { wt[j][0] = *(const f32x4*)(cw + j * 2048 + zc); wt[j][1] = *(const f32x4*)(cw + j * 2048 + zc + 4); }
    wt[4][0] = *(const f32x4*)(cb + zc); wt[4][1] = *(const f32x4*)(cb + zc + 4);
}
DI void qk_conv4(const u32x4 (&xx)[4], const f32x4 (&wt)[5][2], float (&o)[8]) {
    const f32x4 b0 = wt[4][0], b1 = wt[4][1];
    o[0] = b0.x; o[1] = b0.y; o[2] = b0.z; o[3] = b0.w; o[4] = b1.x; o[5] = b1.y; o[6] = b1.z; o[7] = b1.w;
#pragma unroll
    for (int j = 0; j < 4; ++j) { const u32x4 x = xx[j];
        const f32x4 w0 = wt[j][0], w1 = wt[j][1];
        o[0] += w0.x * bfl(x.x); o[1] += w0.y * bfh(x.x); o[2] += w0.z * bfl(x.y); o[3] += w0.w * bfh(x.y); o[4] += w1.x * bfl(x.z); o[5] += w1.y * bfh(x.z); o[6] += w1.z * bfl(x.w); o[7] += w1.w * bfh(x.w); }
#pragma unroll
    for (int i = 0; i < 8; ++i) o[i] = silu(o[i]);
}
DI void phase_ml_local(const Params& p, const Ctx& c) {
    unsigned char* ws = p.ws;
    const bf16* Z = (const bf16*)(ws + WS_Z); const float* GATES = (const float*)(ws + WS_GATES);
    bf16* QC = (bf16*)(ws + WS_QC); bf16* KC = (bf16*)(ws + WS_KC);
    float* BCUM = (float*)(ws + WS_BCUM); float* AVAL = (float*)(ws + WS_AVAL); float* BLAST = (float*)(ws + WS_BLAST); float* AMAX = (float*)(ws + WS_AMAX);
    float* CLOC = (float*)(ws + WS_CLOC); float* NLOC = (float*)(ws + WS_NLOC);
    LAS unsigned char* Vt = c.lds; LAS unsigned char* Kt = c.lds + 32768; LAS float* wL = (LAS float*)(c.lds + 65536);
    const float* cw = p.in[I_E_QKCONV_W]; const float* cb = p.in[I_E_QKCONV_B];
    f32x4 gnx = {0.f, 0.f, 0.f, 0.f};
    auto ldg = [&](int unit) __attribute__((always_inline)) { const int b = unit >> 8, h = (unit >> 5) & 7, cc = unit & 31; const size_t t0 = (size_t)b * SEQ + cc * 128; const int t = 2 * c.lane;
        gnx = (f32x4){GATES[(t0 + t) * 16 + 8 + h], GATES[(t0 + t + 1) * 16 + 8 + h], GATES[(t0 + t) * 16 + h], GATES[(t0 + t + 1) * 16 + h]}; };
    if (c.wave == 0 && c.bid < 1024) ldg(c.bid);
    for (int unit = c.bid; unit < 1024; unit += c.nb) {
        const int b = unit >> 8, h = (unit >> 5) & 7, cc = unit & 31, bh = unit >> 5; const size_t t0 = (size_t)b * SEQ + cc * 128;
        __syncthreads();
        if (c.wave == 0) {
            const int t = 2 * c.lane;
            const float f0 = gnx.x, f1 = gnx.y, i0 = gnx.z, i1 = gnx.w;
            if (unit + c.nb < 1024) ldg(unit + c.nb);
            const float l0 = logsig(f0), l1 = logsig(f1); float incl = l0 + l1;
#pragma unroll
            for (int o = 1; o < 64; o <<= 1) { const float y = __shfl_up(incl, o); if (c.lane >= o) incl += y; }
            const float excl = incl - (l0 + l1), b0 = excl + l0, b1 = excl + l0 + l1, a0 = i0 - b0, a1 = i1 - b1;
            const float amax = wave_max(fmaxf(a0, a1)), blast = __shfl(b1, 63);
            wL[t] = __expf(a0 - amax); wL[t + 1] = __expf(a1 - amax);
            *(f32x2*)(BCUM + (size_t)bh * SEQ + cc * 128 + t) = (f32x2){b0, b1}; *(f32x2*)(AVAL + (size_t)bh * SEQ + cc * 128 + t) = (f32x2){a0, a1};
            if (c.lane == 0) { BLAST[unit * 32] = blast; AMAX[unit * 32] = amax; }
        }
        { u32x4 xq[4][4], xv[4]; f32x4 wt[5][2]; qk_ldw(h * 128 + 8 * (c.tid & 15), cw, cb, wt);
#pragma unroll
            for (int i = 0; i < 4; ++i) { const int idx = c.tid + NTHR * i, r = idx >> 4, ch = idx & 15; const size_t grow = t0 + r;
                qk_load4(Z, grow, cc * 128 + r, h * 128 + 8 * ch, xq[i]); xv[i] = *(const u32x4*)(Z + grow * 4096 + 2048 + h * 128 + 8 * ch); }
#pragma unroll
            for (int i = 0; i < 4; ++i) { const int idx = c.tid + NTHR * i, r = idx >> 4, ch = idx & 15; const size_t grow = t0 + r;
                float o[8];
                qk_conv4(xq[i], wt, o);
                { u32x4 w; w.x = pk2(o[0], o[1]); w.y = pk2(o[2], o[3]); w.z = pk2(o[4], o[5]); w.w = pk2(o[6], o[7]); *(u32x4*)(QC + grow * 1024 + h * 128 + 8 * ch) = w; }
                *(LAS u32x4*)(Vt + toff(r, ch)) = xv[i]; } }
        __syncthreads();
        u32x4 xk[4][4]; f32x4 wk[5][2]; qk_ldw(1024 + h * 128 + 8 * (c.tid & 15), cw, cb, wk);
#pragma unroll
        for (int i = 0; i < 4; ++i) { const int idx = c.tid + NTHR * i, r = idx >> 4, ch = idx & 15; qk_load4(Z, t0 + r, cc * 128 + r, 1024 + h * 128 + 8 * ch, xk[i]); }
#pragma unroll
        for (int i = 0; i < 4; ++i) { const int idx = c.tid + NTHR * i, r = idx >> 4, ch = idx & 15; const size_t grow = t0 + r;
            float o[8];
            qk_conv4(xk[i], wk, o);
#pragma unroll
            for (int j = 0; j < 8; ++j) o[j] *= 0.08838834764831845f;
            { u32x4 w; w.x = pk2(o[0], o[1]); w.y = pk2(o[2], o[3]); w.z = pk2(o[4], o[5]); w.w = pk2(o[6], o[7]); *(u32x4*)(KC + grow * 1024 + h * 128 + 8 * ch) = w; }
            const float wr_ = wL[r];
            { u32x4 w; w.x = pk2(o[0] * wr_, o[1] * wr_); w.y = pk2(o[2] * wr_, o[3] * wr_); w.z = pk2(o[4] * wr_, o[5] * wr_); w.w = pk2(o[6] * wr_, o[7] * wr_); *(LAS u32x4*)(Kt + toff(r, ch)) = w; } }
        __syncthreads();
        {
            const int q = c.lane >> 4, tl = c.lane & 15;
            bf16x8 af[4];
#pragma unroll
            for (int ks = 0; ks < 4; ++ks) af[ks] = cat4(ldtr(Vt, 32 * ks + 8 * q, c.wave, c.lane), ldtr(Vt, 32 * ks + 8 * q + 4, c.wave, c.lane));
            float* outp = CLOC + (size_t)unit * 16384;
            s16x4 kfr[2][8];
#pragma unroll
            for (int ks = 0; ks < 4; ++ks) { kfr[0][2 * ks] = ldtr(Kt, 32 * ks + 8 * q, 0, c.lane); kfr[0][2 * ks + 1] = ldtr(Kt, 32 * ks + 8 * q + 4, 0, c.lane); }
#pragma unroll
            for (int db = 0; db < 8; ++db) { f32x4 acc = {0.f, 0.f, 0.f, 0.f};
                if (db < 7) {
#pragma unroll
                    for (int ks = 0; ks < 4; ++ks) { kfr[(db + 1) & 1][2 * ks] = ldtr(Kt, 32 * ks + 8 * q, db + 1, c.lane); kfr[(db + 1) & 1][2 * ks + 1] = ldtr(Kt, 32 * ks + 8 * q + 4, db + 1, c.lane); } }
                __builtin_amdgcn_sched_barrier(0);
#pragma unroll
                for (int ks = 0; ks < 4; ++ks) acc = MFMA16(cat4(kfr[db & 1][2 * ks], kfr[db & 1][2 * ks + 1]), af[ks], acc);
                *(f32x4*)(outp + (16 * c.wave + tl) * 128 + 16 * db + 4 * q) = acc;
                __builtin_amdgcn_sched_barrier(0); }
        }
        {
            const int d = c.tid & 127, part = c.tid >> 7; float s0 = 0.f, s1 = 0.f;
#pragma unroll
            for (int r = 0; r < 32; r += 2) { s0 += bf1(*(const LAS bf16*)(Kt + toff(32 * part + r, d >> 3) + 2 * (d & 7))); s1 += bf1(*(const LAS bf16*)(Kt + toff(32 * part + r + 1, d >> 3) + 2 * (d & 7))); }
            wL[128 + c.tid] = s0 + s1;
            __syncthreads();
            if (c.tid < 128) NLOC[(size_t)unit * 128 + d] = (wL[128 + d] + wL[256 + d]) + (wL[384 + d] + wL[512 + d]); }
    }
    __syncthreads();
}
DI void phase_ml_scan(const Params& p, const Ctx& c) {
    unsigned char* ws = p.ws;
    const float* BLAST = (const float*)(ws + WS_BLAST); const float* AMAX = (const float*)(ws + WS_AMAX); float* MPREV = (float*)(ws + WS_MPREV);
    const float* CLOC = (const float*)(ws + WS_CLOC); const float* NLOC = (const float*)(ws + WS_NLOC); bf16* CPREV = (bf16*)(ws + WS_CPREV); float* NPREV = (float*)(ws + WS_NPREV);
    const int NT = c.nb * NTHR;
    for (int gid = c.bid * NTHR + c.tid; gid < 32 * 4096 + 32 * 128; gid += NT) {
        if (gid < 32 * 4096) {
            const int bh = gid >> 12, e4 = (gid & 4095) * 4; f32x4 C = {0.f, 0.f, 0.f, 0.f}; float m = 0.f;
#pragma unroll 1
            for (int c0 = 0; c0 < 32; c0 += 8) {
                f32x4 L8[8]; float bl8[8], am8[8];
#pragma unroll
                for (int k = 0; k < 8; ++k) { const int u = bh * 32 + c0 + k; L8[k] = *(const f32x4*)(CLOC + (size_t)u * 16384 + e4); bl8[k] = BLAST[u * 32]; am8[k] = AMAX[u * 32]; }
#pragma unroll
                for (int k = 0; k < 8; ++k) { const int u = bh * 32 + c0 + k; const float bl = bl8[k], ml = bl + am8[k];
                    u32x2 w; w.x = pk2(C.x, C.y); w.y = pk2(C.z, C.w); *(u32x2*)(CPREV + (size_t)u * 16384 + e4) = w;
                    if (e4 == 0) MPREV[u] = m;
                    const float mn = fmaxf(bl + m, ml), dec = __expf(bl + m - mn), sc = __expf(ml - mn);
                    C = C * dec + L8[k] * sc; m = mn; } }
        } else {
            const int g2 = gid - 32 * 4096, bh = g2 >> 7, d = g2 & 127; float n = 0.f, m = 0.f;
#pragma unroll 1
            for (int c0 = 0; c0 < 32; c0 += 8) { float n8[8], bl8[8], am8[8];
#pragma unroll
                for (int k = 0; k < 8; ++k) { const int u = bh * 32 + c0 + k; n8[k] = NLOC[(size_t)u * 128 + d]; bl8[k] = BLAST[u * 32]; am8[k] = AMAX[u * 32]; }
#pragma unroll
                for (int k = 0; k < 8; ++k) { const int u = bh * 32 + c0 + k; const float bl = bl8[k], ml = bl + am8[k];
                    NPREV[(size_t)u * 128 + d] = n;
                    const float mn = fmaxf(bl + m, ml), dec = __expf(bl + m - mn), sc = __expf(ml - mn);
                    n = n * dec + n8[k] * sc; m = mn; } }
        }
    }
}
DI void phase_ml_out(const Params& p, const Ctx& c) {
    unsigned char* ws = p.ws;
    const bf16* Z = (const bf16*)(ws + WS_Z); const bf16* QC = (const bf16*)(ws + WS_QC); const bf16* KC = (const bf16*)(ws + WS_KC); const bf16* CPREV = (const bf16*)(ws + WS_CPREV);
    const float* NPREV = (const float*)(ws + WS_NPREV); const float* MPREV = (const float*)(ws + WS_MPREV); const float* BCUM = (const float*)(ws + WS_BCUM); const float* AVAL = (const float*)(ws + WS_AVAL);
    bf16* MIX = (bf16*)(ws + WS_MIX);
    LAS unsigned char* Qt = c.lds; LAS unsigned char* Kt = c.lds + 32768; LAS unsigned char* Vt = c.lds + 65536; LAS unsigned char* Ct = c.lds + 98304;
    LAS float* aL = (LAS float*)(c.lds + 135168); LAS float* ML = aL + 128; LAS float* bL = aL + 256; LAS float* wsc = aL + 384 + c.wave * 32;
    const int q = c.lane >> 4, tl = c.lane & 15, tb = c.wave;
    for (int unit = c.bid; unit < 1024; unit += c.nb) {
        const int b = unit >> 8, h = (unit >> 5) & 7, cc = unit & 31, bh = unit >> 5; const size_t t0 = (size_t)b * SEQ + cc * 128;
        const float mprev = MPREV[unit];
        __syncthreads();
        if (c.wave == 0) { const int t = 2 * c.lane;
            const f32x2 a = *(const f32x2*)(AVAL + (size_t)bh * SEQ + cc * 128 + t), bb = *(const f32x2*)(BCUM + (size_t)bh * SEQ + cc * 128 + t);
            const float pm1 = fmaxf(a.x, a.y); float incl = pm1;
#pragma unroll
            for (int o = 1; o < 64; o <<= 1) { const float y = __shfl_up(incl, o); if (c.lane >= o) incl = fmaxf(incl, y); }
            float excl = __shfl_up(incl, 1); if (c.lane == 0) excl = mprev; excl = fmaxf(excl, mprev);
            aL[t] = a.x; aL[t + 1] = a.y; ML[t] = fmaxf(excl, a.x); ML[t + 1] = fmaxf(excl, pm1); bL[t] = bb.x; bL[t + 1] = bb.y; }
        { u32x4 t4[4][4];
#pragma unroll
            for (int i = 0; i < 4; ++i) { const int idx = c.tid + NTHR * i, r = idx >> 4, ch = idx & 15; const size_t grow = t0 + r;
                t4[i][0] = *(const u32x4*)(QC + grow * 1024 + h * 128 + 8 * ch); t4[i][1] = *(const u32x4*)(KC + grow * 1024 + h * 128 + 8 * ch);
                t4[i][2] = *(const u32x4*)(Z + grow * 4096 + 2048 + h * 128 + 8 * ch); t4[i][3] = *(const u32x4*)(CPREV + (size_t)unit * 16384 + r * 128 + 8 * ch); }
#pragma unroll
            for (int i = 0; i < 4; ++i) { const int idx = c.tid + NTHR * i, r = idx >> 4, ch = idx & 15;
                *(LAS u32x4*)(Qt + toff(r, ch)) = t4[i][0]; *(LAS u32x4*)(Kt + toff(r, ch)) = t4[i][1]; *(LAS u32x4*)(Vt + toff(r, ch)) = t4[i][2]; *(LAS u32x4*)(Ct + toff(r, ch)) = t4[i][3]; } }
        if (c.tid < 256) { const int r = 128 + (c.tid >> 4), ch = c.tid & 15; u32x4 w = {0u, 0u, 0u, 0u};
            if (r == 128) { const f32x4 n0 = *(const f32x4*)(NPREV + (size_t)unit * 128 + 8 * ch), n1 = *(const f32x4*)(NPREV + (size_t)unit * 128 + 8 * ch + 4); w.x = pk2(n0.x, n0.y); w.y = pk2(n0.z, n0.w); w.z = pk2(n1.x, n1.y); w.w = pk2(n1.z, n1.w); }
            *(LAS u32x4*)(Ct + toff(r, ch)) = w; }
        __syncthreads();
        const size_t trow = t0 + 16 * tb + tl;
        u32x2 zo8[8];
#pragma unroll
        for (int eb = 0; eb < 8; ++eb) zo8[eb] = *(const u32x2*)(Z + trow * 4096 + 3072 + h * 128 + 16 * eb + 4 * q);
        bf16x8 qf[4];
#pragma unroll
        for (int ks = 0; ks < 4; ++ks) qf[ks] = ldrow(Qt, 16 * tb + tl, 4 * ks + q);
        const float Mt = ML[16 * tb + tl];
        f32x4 pp[8]; float dsum = 0.f;
#pragma unroll
        for (int sb = 0; sb < 8; ++sb) {
            pp[sb] = (f32x4){0.f, 0.f, 0.f, 0.f};
            if (sb <= tb) { f32x4 acc = {0.f, 0.f, 0.f, 0.f}; bf16x8 kf[4];
#pragma unroll
                for (int ks = 0; ks < 4; ++ks) kf[ks] = ldrow(Kt, 16 * sb + tl, 4 * ks + q);
                __builtin_amdgcn_sched_barrier(0);
#pragma unroll
                for (int ks = 0; ks < 4; ++ks) acc = MFMA16(kf[ks], qf[ks], acc);
                const f32x4 av = *(const LAS f32x4*)(aL + 16 * sb + 4 * q);
#pragma unroll
                for (int i = 0; i < 4; ++i) { const int s = 16 * sb + 4 * q + i, t = 16 * tb + tl; const float w = (s <= t) ? __expf(av[i] - Mt) : 0.f; pp[sb][i] = acc[i] * w; dsum += pp[sb][i]; } }
        }
        dsum += __shfl_xor(dsum, 16); dsum += __shfl_xor(dsum, 32);
        f32x4 o[8];
#pragma unroll
        for (int eb = 0; eb < 8; ++eb) o[eb] = (f32x4){0.f, 0.f, 0.f, 0.f};
#pragma unroll
        for (int kk = 0; kk < 4; ++kk) if (2 * kk <= tb) { const bf16x8 pf = pack8f(pp[2 * kk], pp[2 * kk + 1]);
            s16x4 vf[16];
#pragma unroll
            for (int eb = 0; eb < 8; ++eb) { vf[2 * eb] = ldtr(Vt, 32 * kk + 4 * q, eb, c.lane); vf[2 * eb + 1] = ldtr(Vt, 32 * kk + 16 + 4 * q, eb, c.lane); }
            __builtin_amdgcn_sched_barrier(0);
#pragma unroll
            for (int eb = 0; eb < 8; ++eb) o[eb] = MFMA16(cat4(vf[2 * eb], vf[2 * eb + 1]), pf, o[eb]);
            __builtin_amdgcn_sched_barrier(0); }
        f32x4 ci[9];
#pragma unroll
        for (int e3 = 0; e3 < 9; e3 += 3) { bf16x8 cfr[3][4];
#pragma unroll
            for (int e = 0; e < 3; ++e)
#pragma unroll
                for (int ks = 0; ks < 4; ++ks) cfr[e][ks] = ldrow(Ct, 16 * (e3 + e) + tl, 4 * ks + q);
            __builtin_amdgcn_sched_barrier(0);
#pragma unroll
            for (int e = 0; e < 3; ++e) { ci[e3 + e] = (f32x4){0.f, 0.f, 0.f, 0.f};
#pragma unroll
                for (int ks = 0; ks < 4; ++ks) ci[e3 + e] = MFMA16(cfr[e][ks], qf[ks], ci[e3 + e]); }
            __builtin_amdgcn_sched_barrier(0); }
        const float qn = __shfl(ci[8][0], tl);
        const float bt = bL[16 * tb + tl], wi = __expf(mprev - Mt), den = dsum + wi * qn, inv = 1.0f / fmaxf(fabsf(den), __expf(-(bt + Mt)));
#pragma unroll
        for (int eb = 0; eb < 8; ++eb) { const int col = h * 128 + 16 * eb + 4 * q; const u32x2 zo = zo8[eb];
            const float h0 = (o[eb][0] + wi * ci[eb][0]) * inv, h1 = (o[eb][1] + wi * ci[eb][1]) * inv, h2 = (o[eb][2] + wi * ci[eb][2]) * inv, h3 = (o[eb][3] + wi * ci[eb][3]) * inv;
            u32x2 wv; wv.x = pk2(sigm(bfl(zo.x)) * h0, sigm(bfh(zo.x)) * h1); wv.y = pk2(sigm(bfl(zo.y)) * h2, sigm(bfh(zo.y)) * h3);
            *(u32x2*)(MIX + trow * 2048 + 1024 + col) = wv; }
    }
    __syncthreads();
}

#define GAS __attribute__((address_space(1)))
#define XB_TMO      128
#define XB_XCNT(j)  (256  + 64 * (j))
#define XB_XSUB(j)  (1280 + 64 * (j))
#define XB_XGEN(j)  (2304 + 64 * (j))
#define XB_TOP      3328
#define XB_TOPGEN   3392
#define XCD_BAR_WORDS 3456
#define XB_SPIN_CAP (1u << 18)

__device__ __forceinline__ unsigned xb_ld(unsigned* p)              { return __hip_atomic_load(p, __ATOMIC_RELAXED, __HIP_MEMORY_SCOPE_AGENT); }
__device__ __forceinline__ unsigned xb_add(unsigned* p, unsigned v) { return __hip_atomic_fetch_add(p, v, __ATOMIC_RELAXED, __HIP_MEMORY_SCOPE_AGENT); }
__device__ __forceinline__ unsigned xb_xcc_id() { return (unsigned)__builtin_amdgcn_s_getreg((3 << 11) | 20) & 0xFu; }
#define XB_SPIN(cond, bar) do { unsigned _sp = 0; while (cond) { __builtin_amdgcn_s_sleep(1); \
    if ((++_sp & 255u) == 0u) { if (xb_ld(&(bar)[XB_TMO])) break; if (_sp > XB_SPIN_CAP) { atomicAdd(&(bar)[XB_TMO], 1u); break; } } } } while (0)

struct XcdBarrier {
    unsigned* bar; unsigned x;
    volatile LAS unsigned* st;
};

__device__ __forceinline__ XcdBarrier xcd_barrier_post(unsigned* bar, volatile LAS unsigned* st) {
    XcdBarrier b; b.bar = bar; b.x = xb_xcc_id(); b.st = st;
    if (threadIdx.x == 0) (void)xb_add(&bar[XB_XCNT(b.x)], 1u);
    return b;
}
__device__ __forceinline__ void xcd_barrier_complete(unsigned* bar, unsigned x, unsigned& nloc, unsigned& nx) {
    const unsigned G = gridDim.x * gridDim.y * gridDim.z;
    unsigned sum, cnt, mine, sp = 0u;
    for (;;) {
        sum = 0u; cnt = 0u; mine = 0u;
#pragma unroll
        for (unsigned j = 0; j < 16; ++j) { const unsigned c = xb_ld(&bar[XB_XCNT(j)]); sum += c; cnt += (c > 0u) ? 1u : 0u; mine = (j == x) ? c : mine; }
        if (sum == G) break;
        __builtin_amdgcn_s_sleep(1);
        if ((++sp & 255u) == 0u) { if (xb_ld(&bar[XB_TMO])) break; if (sp > XB_SPIN_CAP) { atomicAdd(&bar[XB_TMO], 1u); break; } }
    }
    nloc = mine > 0u ? mine : 1u; nx = cnt > 0u ? cnt : 1u;
}

__device__ __forceinline__ void xcd_barrier(const XcdBarrier& b) {
    asm volatile("s_waitcnt vmcnt(0)" ::: "memory");
    __syncthreads();
    if (threadIdx.x == 0) {
        unsigned* bar = b.bar;
        __builtin_amdgcn_s_waitcnt(0);
        unsigned nloc = b.st[0], nx = b.st[1];
        if (nloc == 0u) { xcd_barrier_complete(bar, b.x, nloc, nx); b.st[0] = nloc; b.st[1] = nx; }
        const unsigned old = xb_add(&bar[XB_XSUB(b.x)], 1u);
        const unsigned gen = old / nloc;
        if (old + 1u == (gen + 1u) * nloc) {
            __builtin_amdgcn_fence(__ATOMIC_RELEASE, "agent");
            asm volatile("s_waitcnt vmcnt(0)" ::: "memory");
            const unsigned og = xb_add(&bar[XB_TOP], 1u);
            const unsigned tg = og / nx;
            if (og + 1u == (tg + 1u) * nx) xb_add(&bar[XB_TOPGEN], 1u);
            else XB_SPIN(xb_ld(&bar[XB_TOPGEN]) == tg, bar);
            __builtin_amdgcn_fence(__ATOMIC_ACQUIRE, "agent");
            xb_add(&bar[XB_XGEN(b.x)], 1u);
            asm volatile("s_waitcnt vmcnt(0)" ::: "memory");
        } else {
            XB_SPIN(xb_ld(&bar[XB_XGEN(b.x)]) == gen, bar);
            __builtin_amdgcn_fence(__ATOMIC_ACQUIRE, "agent");
            asm volatile("s_waitcnt vmcnt(0)" ::: "memory");
        }
    }
    __syncthreads();
}
DI void at_load(const bf16* QKV, size_t rowb, int ck, int r, int res, int h, int tid, u32x4 (&kv)[4], u32x4 (&vv)[4]) {
    const unsigned lo = ((unsigned)((tid >> 4) * r) * 3072u + 8u * (unsigned)(tid & 15)) * 2u;
#pragma unroll
    for (int i = 0; i < 4; ++i) {
        kv[i] = (u32x4){0u, 0u, 0u, 0u}; vv[i] = (u32x4){0u, 0u, 0u, 0u};
        if (ck >= 0) { const char* ub = (const char*)(QKV + (rowb + (size_t)(128 * ck + 32 * i) * r + res) * 3072 + h * 128); kv[i] = *(const u32x4*)(ub + 2048 + lo); vv[i] = *(const u32x4*)(ub + 4096 + lo); } }
}
DI void at_store(LAS unsigned char* Kt, LAS unsigned char* Vt, int ck, int tid, const u32x4 (&kv)[4], const u32x4 (&vv)[4]) {
    const int base = (ck & 1) * 128;
#pragma unroll
    for (int i = 0; i < 4; ++i) { const int idx = tid + NTHR * i, ki = idx >> 4, ch = idx & 15; *(LAS u32x4*)(Kt + toff(base + ki, ch)) = kv[i]; *(LAS u32x4*)(Vt + toff(base + ki, ch)) = vv[i]; }
}
DI void at_loadq(const bf16* QKV, size_t rowb, int n0, int r, int res, int h, int tl, int q, bf16x8 (&qf)[4]) {
    const char* ub = (const char*)(QKV + (rowb + (size_t)n0 * r + res) * 3072 + h * 128);
    const unsigned lo = ((unsigned)(tl * r) * 3072u + 8u * (unsigned)q) * 2u;
#pragma unroll
    for (int ks = 0; ks < 4; ++ks) qf[ks] = *(const bf16x8*)(ub + lo + 64 * ks);
}
struct AtRun { int g, b, h, res, nbk0, nblk; };
DI void at_decode(int unit, AtRun& R) {
    if (unit < 512) { R.g = unit >> 8; const int idx = unit & 255, rr = idx & 7; R.b = idx >> 6; R.h = (idx >> 3) & 7; R.res = R.g ? (rr >> 1) : 0; R.nbk0 = R.g ? 4 * (rr & 1) : 4 * rr; R.nblk = 4; }
    else { R.g = 2; const int idx = unit - 512; R.b = idx >> 7; R.h = (idx >> 4) & 7; R.res = idx & 15; R.nbk0 = 0; R.nblk = 2; }
}
DI void phase_attn(const Params& p, const Ctx& c) {
    unsigned char* ws = p.ws;
    const bf16* QKV = (const bf16*)(ws + WS_QKV); bf16* OG = (bf16*)(ws + WS_OG); float* MXL = (float*)(ws + WS_MXL);
    LAS unsigned char* Kt = c.lds; LAS unsigned char* Vt = c.lds + 65536;
    const int q = c.lane >> 4, tl = c.lane & 15, w = c.wave;
    int klo[4], vlo[8];
#pragma unroll
    for (int ks = 0; ks < 4; ++ks) klo[ks] = toff(tl, 4 * ks + q);
#pragma unroll
    for (int eb = 0; eb < 8; ++eb) vlo[eb] = toff(4 * q + (tl >> 2), 2 * eb + ((tl & 3) >> 1)) + 8 * (tl & 1);
    u32x4 kv[4], vv[4]; bf16x8 qf[4];
    AtRun R; int unit = c.bid;
    if (unit < 1024) { at_decode(unit, R); at_load(QKV, (size_t)R.b * SEQ, R.nbk0 - 1, 1 << (2 * R.g), R.res, R.h, c.tid, kv, vv); }
    for (; unit < 1024; unit += c.nb) {
        const int g = R.g, b = R.b, h = R.h, res = R.res, nbk0 = R.nbk0, nblk = R.nblk;
        const int lr = 2 * g, r = 1 << lr;
        const size_t rowb = (size_t)b * SEQ;
        const bool more = unit + c.nb < 1024;
        __syncthreads();
        at_store(Kt, Vt, nbk0 - 1, c.tid, kv, vv);
        at_load(QKV, rowb, nbk0, r, res, h, c.tid, kv, vv);
        at_loadq(QKV, rowb, 128 * nbk0 + 16 * w, r, res, h, tl, q, qf);
        for (int j = 0; j < nblk; ++j) {
            const int nbk = nbk0 + j;
            if (j) __syncthreads();
            at_store(Kt, Vt, nbk, c.tid, kv, vv);
            __syncthreads();
            const int nq = 128 * nbk + 16 * w + tl;
            const size_t qrow = rowb + (size_t)nq * r + res;
            if (j + 1 < nblk) at_load(QKV, rowb, nbk + 1, r, res, h, c.tid, kv, vv);
            else if (more) { at_decode(unit + c.nb, R); at_load(QKV, (size_t)R.b * SEQ, R.nbk0 - 1, 1 << (2 * R.g), R.res, R.h, c.tid, kv, vv); }
#ifdef PROBE_ATTC
#pragma unroll 1
            for (int rep2 = 0; rep2 < 2; ++rep2) { asm volatile("" ::: "memory");
#endif
            const int f8 = ((nbk - 1) & 1) << 3;
            const int kb0 = 2 * (w >> 1), qi = 16 * w + tl;
            const int lo2 = nbk == 0 ? 128 - qi : 0, d0 = 16 * kb0 + 4 * q - qi - lo2; const unsigned hb = (unsigned)(128 - lo2);
            f32x4 sc[10]; float mx = -3.0e38f;
            bf16x8 kf[2][8];
#pragma unroll
            for (int s2 = 0; s2 < 2; ++s2)
#pragma unroll
                for (int ks = 0; ks < 4; ++ks) kf[0][4 * s2 + ks] = *(const LAS bf16x8*)(Kt + (((kb0 + s2) ^ f8) << 12) + klo[ks]);
#pragma unroll
            for (int pp = 0; pp < 5; ++pp) {
                if (pp < 4) {
#pragma unroll
                    for (int s2 = 0; s2 < 2; ++s2)
#pragma unroll
                        for (int ks = 0; ks < 4; ++ks) kf[(pp + 1) & 1][4 * s2 + ks] = *(const LAS bf16x8*)(Kt + (((kb0 + 2 * pp + 2 + s2) ^ f8) << 12) + klo[ks]); }
                __builtin_amdgcn_sched_barrier(0);
#pragma unroll
                for (int s2 = 0; s2 < 2; ++s2) { const int sb = 2 * pp + s2; f32x4 acc = {0.f, 0.f, 0.f, 0.f};
#pragma unroll
                    for (int ks = 0; ks < 4; ++ks) acc = MFMA16(kf[pp & 1][4 * s2 + ks], qf[ks], acc);
#pragma unroll
                    for (int i = 0; i < 4; ++i) { const bool ok = (unsigned)(d0 + 16 * sb + i) <= hb;
                        acc[i] = ok ? acc[i] : -3.0e38f; mx = fmaxf(mx, acc[i]); }
                    sc[sb] = acc; }
                __builtin_amdgcn_sched_barrier(0);
            }
            s16x4 vf[2][16];
#pragma unroll
            for (int eb = 0; eb < 8; ++eb) { vf[0][2 * eb] = __builtin_bit_cast(s16x4, __builtin_amdgcn_ds_read_tr16_b64_v4i16((LAS s16x4*)(Vt + (((kb0) ^ f8) << 12) + vlo[eb])));
                vf[0][2 * eb + 1] = __builtin_bit_cast(s16x4, __builtin_amdgcn_ds_read_tr16_b64_v4i16((LAS s16x4*)(Vt + (((kb0 + 1) ^ f8) << 12) + vlo[eb]))); }
            __builtin_amdgcn_sched_barrier(0);
#ifndef PROBE_ATTC
            if (j + 1 < nblk) at_loadq(QKV, rowb, 128 * (nbk + 1) + 16 * w, r, res, h, tl, q, qf);
#endif
            mx = fmaxf(mx, __shfl_xor(mx, 16)); mx = fmaxf(mx, __shfl_xor(mx, 32));
            float l = 0.f; const float mxl = -1.4426950408889634f * mx;
#pragma unroll
            for (int sb = 0; sb < 10; ++sb)
#pragma unroll
                for (int i = 0; i < 4; ++i) { const float e = __builtin_amdgcn_exp2f(__builtin_fmaf(sc[sb][i], 1.4426950408889634f, mxl)); sc[sb][i] = e; l += e; }
            l += __shfl_xor(l, 16); l += __shfl_xor(l, 32);
            f32x4 o[8];
#pragma unroll
            for (int eb = 0; eb < 8; ++eb) o[eb] = (f32x4){0.f, 0.f, 0.f, 0.f};
#pragma unroll
            for (int kk = 0; kk < 5; ++kk) { const bf16x8 pf = pack8f(sc[2 * kk], sc[2 * kk + 1]);
                if (kk < 4) {
#pragma unroll
                    for (int eb = 0; eb < 8; ++eb) { vf[(kk + 1) & 1][2 * eb] = __builtin_bit_cast(s16x4, __builtin_amdgcn_ds_read_tr16_b64_v4i16((LAS s16x4*)(Vt + (((kb0 + 2 * kk + 2) ^ f8) << 12) + vlo[eb])));
                        vf[(kk + 1) & 1][2 * eb + 1] = __builtin_bit_cast(s16x4, __builtin_amdgcn_ds_read_tr16_b64_v4i16((LAS s16x4*)(Vt + (((kb0 + 2 * kk + 3) ^ f8) << 12) + vlo[eb]))); } }
                __builtin_amdgcn_sched_barrier(0);
#pragma unroll
                for (int eb = 0; eb < 8; ++eb) o[eb] = MFMA16(cat4(vf[kk & 1][2 * eb], vf[kk & 1][2 * eb + 1]), pf, o[eb]);
                __builtin_amdgcn_sched_barrier(0); }
            if (q == 0) *(f32x2*)(MXL + ((((size_t)(g * 4 + b) * 8 + h) * SEQ) + (size_t)res * (SEQ >> lr) + nq) * 2) = (f32x2){mx, l};
            bf16* og = OG + (size_t)g * M * 1024 + qrow * 1024 + h * 128 + 4 * q;
#pragma unroll
            for (int eb = 0; eb < 8; ++eb) { u32x2 wv; wv.x = pk2(o[eb][0], o[eb][1]); wv.y = pk2(o[eb][2], o[eb][3]); *(u32x2*)(og + 16 * eb) = wv; }
#ifdef PROBE_ATTC
            }
#endif
        }
    }
    __syncthreads();
}
DI void phase_attn_merge(const Params& p, const Ctx& c) {
    unsigned char* ws = p.ws; const bf16* OG = (const bf16*)(ws + WS_OG); const float* MXL = (const float*)(ws + WS_MXL); bf16* MIX = (bf16*)(ws + WS_MIX);
    const int NT = c.nb * NTHR;
    for (int idx0 = c.bid * NTHR + c.tid; idx0 < M * 128; idx0 += 4 * NT) {
        f32x2 ml[4][3]; u32x4 x[4][3];
#pragma unroll
        for (int i = 0; i < 4; ++i) { const int idx = idx0 + i * NT < M * 128 ? idx0 + i * NT : idx0; const int t = idx >> 7, hc = idx & 127, h = hc >> 4;
#pragma unroll
            for (int g = 0; g < 3; ++g) { const int lr = 2 * g, bq = t >> 12, pos = t & (SEQ - 1), res = pos & ((1 << lr) - 1), n = pos >> lr;
                ml[i][g] = *(const f32x2*)(MXL + ((((size_t)(g * 4 + bq) * 8 + h) * SEQ) + (size_t)res * (SEQ >> lr) + n) * 2);
                x[i][g] = *(const u32x4*)(OG + ((size_t)g * M + t) * 1024 + 8 * hc); } }
#pragma unroll
        for (int i = 0; i < 4; ++i) { const int idx = idx0 + i * NT; if (idx >= M * 128) break; const int t = idx >> 7, hc = idx & 127;
            const float MX = fmaxf(fmaxf(ml[i][0].x, ml[i][1].x), ml[i][2].x);
            float wg[3], den = 0.f;
#pragma unroll
            for (int g = 0; g < 3; ++g) { wg[g] = __expf(ml[i][g].x - MX); den += wg[g] * ml[i][g].y; }
            const float inv = 1.0f / den; float a[8] = {0.f, 0.f, 0.f, 0.f, 0.f, 0.f, 0.f, 0.f};
#pragma unroll
            for (int g = 0; g < 3; ++g) { const u32x4 xx = x[i][g]; const float sw = wg[g] * inv;
                a[0] += sw * bfl(xx.x); a[1] += sw * bfh(xx.x); a[2] += sw * bfl(xx.y); a[3] += sw * bfh(xx.y); a[4] += sw * bfl(xx.z); a[5] += sw * bfh(xx.z); a[6] += sw * bfl(xx.w); a[7] += sw * bfh(xx.w); }
            u32x4 o; o.x = pk2(a[0], a[1]); o.y = pk2(a[2], a[3]); o.z = pk2(a[4], a[5]); o.w = pk2(a[6], a[7]);
            *(u32x4*)(MIX + (size_t)t * 2048 + 8 * hc) = o; }
    }
}

DI void cmul_add(float& xr, float& xi, float lr, float li, float br, float bi) {
    float nr = __builtin_fmaf(lr, xr, __builtin_fmaf(-li, xi, br)), ni = __builtin_fmaf(lr, xi, __builtin_fmaf(li, xr, bi));
    asm volatile("" : "+v"(nr), "+v"(ni));
    xr = nr; xi = ni; }
DI void phase_s5(const Params& p, const Ctx& c) {
    unsigned char* ws = p.ws; const bf16* U = (const bf16*)(ws + WS_U); bf16* Y = (bf16*)(ws + WS_Y);
    LAS unsigned char* Xw = c.lds + c.wave * 8192; LAS float* endL = (LAS float*)(c.lds + 65536);
    const int j = c.lane & 31, hh = c.lane >> 5, q4 = c.lane >> 4, tl = c.lane & 15, w = c.wave;
    for (int unit = c.bid; unit < 256; unit += c.nb) {
        const int b = unit >> 6, g = unit & 63;
        const float dt = __expf(p.in[I_O_LOG_DT][g]);
        float lbr[2], lbi[2], L256r[2], L256i[2]; bf16x8 bfr[4];
#pragma unroll
        for (int s = 0; s < 2; ++s) { const int st = g * 64 + 32 * s + j; const float lr = p.in[I_O_LAM_RE][st], li = p.in[I_O_LAM_IM][st];
            const float mag = expf(lr * dt); float sn, cs; sincosf(li * dt, &sn, &cs); lbr[s] = mag * cs; lbi[s] = mag * sn;
            const float dn = 1.0f / (lr * lr + li * li), cr = ((lbr[s] - 1.0f) * lr + lbi[s] * li) * dn, cim = (lbi[s] * lr - (lbr[s] - 1.0f) * li) * dn;
            const f32x4 br0 = *(const f32x4*)(p.in[I_O_B_RE] + (size_t)st * 16 + 8 * hh), br1 = *(const f32x4*)(p.in[I_O_B_RE] + (size_t)st * 16 + 8 * hh + 4);
            const f32x4 bi0 = *(const f32x4*)(p.in[I_O_B_IM] + (size_t)st * 16 + 8 * hh), bi1 = *(const f32x4*)(p.in[I_O_B_IM] + (size_t)st * 16 + 8 * hh + 4);
            bfr[s] = pack8f(br0 * cr - bi0 * cim, br1 * cr - bi1 * cim); bfr[2 + s] = pack8f(bi0 * cr + br0 * cim, bi1 * cr + br1 * cim);
            float pr = lbr[s], pi = lbi[s];
#pragma unroll
            for (int k = 0; k < 8; ++k) { const float nr = pr * pr - pi * pi, ni = 2.0f * pr * pi; pr = nr; pi = ni; }
            L256r[s] = pr; L256i[s] = pi; }
        bf16x8 cf[4];
#pragma unroll
        for (int ks = 0; ks < 4; ++ks) { const size_t o = ((size_t)g * 16 + tl) * 64 + 16 * ks + 4 * q4; const f32x4 cr = *(const f32x4*)(p.in[I_O_C_RE] + o), ci = *(const f32x4*)(p.in[I_O_C_IM] + o);
            u32x4 wv; wv.x = pk2m(cr.x, -ci.x); wv.y = pk2m(cr.y, -ci.y); wv.z = pk2m(cr.z, -ci.z); wv.w = pk2m(cr.w, -ci.w); cf[ks] = __builtin_bit_cast(bf16x8, wv); }
        const f32x4 dsk4 = *(const f32x4*)(p.in[I_O_D_SKIP] + 16 * g + 4 * q4);
        const size_t rowb = (size_t)b * SEQ;
        const int arow = c.lane & 31, akh = c.lane >> 5;
        const size_t atok0 = rowb + 256 * (2 * w + ((arow >> 2) & 1)) + 4 * (arow >> 3) + (arow & 3);
        const f32x16 z16 = {0.f, 0.f, 0.f, 0.f, 0.f, 0.f, 0.f, 0.f, 0.f, 0.f, 0.f, 0.f, 0.f, 0.f, 0.f, 0.f};
        float xr[2] = {0.f, 0.f}, xi[2] = {0.f, 0.f};
        bf16x8 ur[4];
#pragma unroll
        for (int k = 0; k < 4; ++k) ur[k] = *(const bf16x8*)(U + (atok0 + 16 * k) * 1024 + 16 * g + 8 * akh);
#pragma unroll 1
        for (int it0 = 0; it0 < 16; it0 += 4) {
#pragma unroll
            for (int k = 0; k < 4; ++k) { const bf16x8 uf = ur[k]; ur[k] = *(const bf16x8*)(U + (atok0 + 16 * ((it0 + k + 4) & 15)) * 1024 + 16 * g + 8 * akh);
                const f32x16 b0 = MFMA32(uf, bfr[0], z16), b1 = MFMA32(uf, bfr[1], z16), b2 = MFMA32(uf, bfr[2], z16), b3 = MFMA32(uf, bfr[3], z16);
#pragma unroll
                for (int r = 0; r < 16; ++r) { cmul_add(xr[0], xi[0], lbr[0], lbi[0], b0[r], b2[r]); cmul_add(xr[1], xi[1], lbr[1], lbi[1], b1[r], b3[r]); } } }
        u32x2 uu0[4][2];
#pragma unroll
        for (int jt = 0; jt < 4; ++jt)
#pragma unroll
            for (int sc = 0; sc < 2; ++sc) uu0[jt][sc] = *(const u32x2*)(U + (rowb + 256 * (2 * w + sc) + 16 * jt + tl) * 1024 + 16 * g + 4 * q4);
        __syncthreads();
        { const int ss = 2 * w + hh; *(LAS f32x2*)(endL + (ss * 64 + j) * 2) = (f32x2){xr[0], xi[0]}; *(LAS f32x2*)(endL + (ss * 64 + 32 + j) * 2) = (f32x2){xr[1], xi[1]}; }
        __syncthreads();
        { const int ss = 2 * w + hh; xr[0] = xi[0] = xr[1] = xi[1] = 0.f;
            for (int s2 = 0; s2 < ss; ++s2) { const f32x2 e0 = *(const LAS f32x2*)(endL + (s2 * 64 + j) * 2), e1 = *(const LAS f32x2*)(endL + (s2 * 64 + 32 + j) * 2);
                cmul_add(xr[0], xi[0], L256r[0], L256i[0], e0.x, e0.y); cmul_add(xr[1], xi[1], L256r[1], L256i[1], e1.x, e1.y); } }
        auto trip = [&](int it4, const bf16x8 (&u4)[4], const u32x2 (&uu4)[4][2]) __attribute__((always_inline)) {
#pragma unroll
            for (int jt = 0; jt < 4; ++jt) { const int it = 4 * it4 + jt; const bf16x8 uf = u4[jt];
                const f32x16 b0 = MFMA32(uf, bfr[0], z16), b1 = MFMA32(uf, bfr[1], z16), b2 = MFMA32(uf, bfr[2], z16), b3 = MFMA32(uf, bfr[3], z16);
#pragma unroll
                for (int r = 0; r < 16; ++r) { cmul_add(xr[0], xi[0], lbr[0], lbi[0], b0[r], b2[r]); cmul_add(xr[1], xi[1], lbr[1], lbi[1], b1[r], b3[r]);
                    const int row = 16 * hh + r;
                    *(LAS unsigned*)(Xw + toff(row, j >> 2) + 4 * (j & 3)) = pk2(xr[0], xi[0]);
                    *(LAS unsigned*)(Xw + toff(row, 8 + (j >> 2)) + 4 * (j & 3)) = pk2(xr[1], xi[1]); }
                LDS_WAIT();
                bf16x8 xs[2][4];
#pragma unroll
                for (int sc = 0; sc < 2; ++sc)
#pragma unroll
                    for (int ks = 0; ks < 4; ++ks) xs[sc][ks] = ldrow(Xw, 16 * sc + tl, 4 * ks + q4);
                __builtin_amdgcn_sched_barrier(0);
#pragma unroll
                for (int sc = 0; sc < 2; ++sc) { f32x4 acc = {0.f, 0.f, 0.f, 0.f};
#pragma unroll
                    for (int ks = 0; ks < 4; ++ks) acc = MFMA16(cf[ks], xs[sc][ks], acc);
                    const size_t t = rowb + 256 * (2 * w + sc) + 16 * it + tl; const size_t o = t * 1024 + 16 * g + 4 * q4; const u32x2 uu = uu4[jt][sc];
                    float y[4] = {acc[0] + dsk4.x * bfl(uu.x), acc[1] + dsk4.y * bfh(uu.x), acc[2] + dsk4.z * bfl(uu.y), acc[3] + dsk4.w * bfh(uu.y)};
#pragma unroll
                    for (int i = 0; i < 4; ++i) { const float z = 1.5957691216057308f * (y[i] + 0.044715f * y[i] * y[i] * y[i]); y[i] = y[i] * sigm(z); }
                    __hip_atomic_store((unsigned long long*)(Y + o), ((unsigned long long)pk2(y[2], y[3]) << 32) | (unsigned long long)pk2(y[0], y[1]), __ATOMIC_RELAXED, __HIP_MEMORY_SCOPE_AGENT); }
                LDS_WAIT(); }
        };
        trip(0, ur, uu0);
#pragma unroll 1
        for (int it4 = 1; it4 < 4; ++it4) {
            bf16x8 u4[4]; u32x2 uu4[4][2];
#pragma unroll
            for (int jt = 0; jt < 4; ++jt) { const int it = 4 * it4 + jt; u4[jt] = *(const bf16x8*)(U + (atok0 + 16 * it) * 1024 + 16 * g + 8 * akh);
#pragma unroll
                for (int sc = 0; sc < 2; ++sc) uu4[jt][sc] = *(const u32x2*)(U + (rowb + 256 * (2 * w + sc) + 16 * it + tl) * 1024 + 16 * g + 4 * q4); }
            trip(it4, u4, uu4);
        }
        __syncthreads();
    }
}

DI void phase_route(const Params& p, const Ctx& c) {
    unsigned char* ws = p.ws; LAS float* WR = (LAS float*)c.lds; LAS int* cntL = (LAS int*)(c.lds + 65536);
    int* TOKE = (int*)(ws + WS_TOKE); float* TOKG = (float*)(ws + WS_TOKG); int* CNT = (int*)(ws + WS_CNT); bf16* XN = (bf16*)(ws + WS_XN);
    __syncthreads();
    for (int idx = c.tid; idx < D * 8; idx += NTHR) { const int k = idx >> 3, e = idx & 7; WR[e * D + k] = p.in[I_O_ROUTER][idx]; }
    f32x4 gg[8]; rms_ldg(p.in[I_O_NORM_FFN], c.lane, gg);
    for (int tb = c.bid; tb < 256; tb += c.nb) {
        __syncthreads();
        if (c.tid < 8) cntL[c.tid] = 0;
        __syncthreads();
        for (int i = 0; i < 8; i += 2) { const int m = 64 * tb + 8 * c.wave + i;
            asm volatile("" ::: "memory");
            f32x4 va[8], vb[8]; rms_row<true>(p.out + (size_t)m * D, gg, (unsigned char*)XN + (size_t)m * D, c.lane, va);
            rms_row<true>(p.out + (size_t)(m + 1) * D, gg, (unsigned char*)XN + (size_t)(m + 1) * D, c.lane, vb);
            float aa[8], ab[8];
#pragma unroll
            for (int e = 0; e < 8; ++e) { float s0 = 0.f, s1 = 0.f;
#pragma unroll
                for (int jj = 0; jj < 8; ++jj) { const f32x4 wv = *(const LAS f32x4*)(WR + e * D + 4 * c.lane + 256 * jj);
                    s0 += (va[jj].x * wv.x + va[jj].y * wv.y) + (va[jj].z * wv.z + va[jj].w * wv.w); s1 += (vb[jj].x * wv.x + vb[jj].y * wv.y) + (vb[jj].z * wv.z + vb[jj].w * wv.w); }
                aa[e] = s0; ab[e] = s1; }
            const float ea = xreduce8(aa, c.lane), eb = xreduce8(ab, c.lane);
#pragma unroll
            for (int rr = 0; rr < 2; ++rr) { const float ev = rr ? eb : ea; float lg[8];
#pragma unroll
                for (int e = 0; e < 8; ++e) lg[e] = __builtin_bit_cast(float, __builtin_amdgcn_readlane(__builtin_bit_cast(int, ev), 8 * e));
                int i1 = 0; float v1 = lg[0];
#pragma unroll
                for (int e = 1; e < 8; ++e) if (lg[e] > v1) { v1 = lg[e]; i1 = e; }
                int i2 = -1; float v2 = -3.0e38f;
#pragma unroll
                for (int e = 0; e < 8; ++e) if (e != i1 && lg[e] > v2) { v2 = lg[e]; i2 = e; }
                if (c.lane == 0) { const float g1 = 1.0f / (1.0f + expf(v2 - v1)); *(int2*)(TOKE + 2 * (m + rr)) = make_int2(i1, i2); *(f32x2*)(TOKG + 2 * (m + rr)) = (f32x2){g1, 1.0f - g1};
                    atomicAdd((int*)(cntL + i1), 1); atomicAdd((int*)(cntL + i2), 1); } } }
        __syncthreads();
        if (c.tid < 8) CNT[tb * 32 + c.tid] = cntL[c.tid];
    }
    __syncthreads();
}
DI void phase_assign(const Params& p, const Ctx& c) {
    unsigned char* ws = p.ws; const int* TOKE = (const int*)(ws + WS_TOKE); int* SLOT = (int*)(ws + WS_SLOT); const int* CNT = (const int*)(ws + WS_CNT); int* TILEE = (int*)(ws + WS_TILEE);
    const bf16* XN = (const bf16*)(ws + WS_XN); bf16* XG = (bf16*)(ws + WS_XG);
    LAS int* cL = (LAS int*)c.lds; LAS int* tot = cL + 2048; LAS int* pre = tot + 8; LAS int* slotL = pre + 8;
    for (int tb = c.bid; tb < 256; tb += c.nb) {
        __syncthreads();
        for (int i = c.tid; i < 2048; i += NTHR) cL[i] = CNT[(i >> 3) * 32 + (i & 7)];
        __syncthreads();
        {
            const int e = c.wave; int t = 0, pr = 0;
#pragma unroll
            for (int k = 0; k < 4; ++k) { const int bb = 4 * c.lane + k, v = cL[bb * 8 + e]; t += v; pr += bb < tb ? v : 0; }
#pragma unroll
            for (int o = 1; o < 64; o <<= 1) { t += __shfl_xor(t, o); pr += __shfl_xor(pr, o); }
            if (c.lane == 0) { tot[e] = t; pre[e] = pr; } }
        __syncthreads();
        int base[8]; { int a = 0;
#pragma unroll
            for (int e = 0; e < 8; ++e) { base[e] = a; a += (tot[e] + 255) & ~255; } }
        if (c.wave == 0) { const int m = 64 * tb + c.lane; const int2 ee = *(const int2*)(TOKE + 2 * m); int s1 = 0, s2 = 0;
#pragma unroll
            for (int e = 0; e < 8; ++e) { const bool sel = (ee.x == e) || (ee.y == e); const unsigned long long bal = __ballot(sel);
                const int rank = __popcll(bal & ((1ull << c.lane) - 1ull)); const int sl = base[e] + pre[e] + rank; if (ee.x == e) s1 = sl; if (ee.y == e) s2 = sl; }
            *(int2*)(SLOT + 2 * m) = make_int2(s1, s2); slotL[2 * c.lane] = s1; slotL[2 * c.lane + 1] = s2; }
        __syncthreads();
        for (int rr0 = c.wave; rr0 < 128; rr0 += 4 * NWAVES) {
            u32x4 t[4][2];
#pragma unroll
            for (int i = 0; i < 4; ++i) { const int rr = rr0 + NWAVES * i, m = 64 * tb + (rr >> 1); const u32x4* src = (const u32x4*)((const unsigned char*)XN + (size_t)m * D);
#pragma unroll
                for (int k = 0; k < 2; ++k) t[i][k] = src[c.lane + 64 * k]; }
#pragma unroll
            for (int i = 0; i < 4; ++i) { const int rr = rr0 + NWAVES * i; u32x4* dst = (u32x4*)((unsigned char*)XG + (size_t)slotL[rr] * D);
#pragma unroll
                for (int k = 0; k < 2; ++k) dst[c.lane + 64 * k] = t[i][k]; } }
        if (tb < 8) {
            const int e = tb, r0 = base[e] + tot[e], r1 = base[e] + ((tot[e] + 255) & ~255);
            for (int rr = r0 + c.wave; rr < r1; rr += NWAVES) { u32x4* dst = (u32x4*)((unsigned char*)XG + (size_t)rr * D);
#pragma unroll
                for (int k = 0; k < 2; ++k) dst[c.lane + 64 * k] = (u32x4){0u, 0u, 0u, 0u}; } }
        if (tb == 0 && c.tid < 256) { int nt = 0, mye = 0;
#pragma unroll
            for (int e = 0; e < 8; ++e) { const int n = (tot[e] + 255) >> 8; if (c.tid >= nt && c.tid < nt + n) mye = e; nt += n; }
            TILEE[c.tid] = (c.tid == 255) ? nt : mye; }
    }
    __syncthreads();
}
DI void phase_final(const Params& p, const Ctx& c) {
    unsigned char* ws = p.ws; const int* SLOT = (const int*)(ws + WS_SLOT); const float* TOKG = (const float*)(ws + WS_TOKG); const bf16* YG = (const bf16*)(ws + WS_XG);
    const int gw = c.bid * NWAVES + c.wave, NGW = c.nb * NWAVES;
    f32x4 gg[8]; rms_ldg(p.in[I_FINAL_NORM], c.lane, gg);
    int2 sln = make_int2(0, 0); f32x2 gtn = {0.f, 0.f};
    if (gw < M) { sln = *(const int2*)(SLOT + 2 * gw); gtn = *(const f32x2*)(TOKG + 2 * gw); }
    for (int m = gw; m < M; m += NGW) { const int2 sl = sln; const f32x2 gt = gtn;
        if (m + NGW < M) { sln = *(const int2*)(SLOT + 2 * (m + NGW)); gtn = *(const f32x2*)(TOKG + 2 * (m + NGW)); }
        float* xrow = p.out + (size_t)m * D; const bf16* y1 = YG + (size_t)sl.x * D; const bf16* y2 = YG + (size_t)sl.y * D;
        f32x4 v[8]; float s = 0.f;
#pragma unroll
        for (int j = 0; j < 8; ++j) { const int k = 4 * c.lane + 256 * j; v[j] = *(const f32x4*)(xrow + k); const u32x2 a = *(const u32x2*)(y1 + k), bq = *(const u32x2*)(y2 + k);
            v[j].x += gt.x * bfl(a.x) + gt.y * bfl(bq.x); v[j].y += gt.x * bfh(a.x) + gt.y * bfh(bq.x); v[j].z += gt.x * bfl(a.y) + gt.y * bfl(bq.y); v[j].w += gt.x * bfh(a.y) + gt.y * bfh(bq.y);
            s += (v[j].x * v[j].x + v[j].y * v[j].y) + (v[j].z * v[j].z + v[j].w * v[j].w); }
        const float rstd = rsqrtf(wave_sum(s) * (1.0f / D) + RMS_EPS);
#pragma unroll
        for (int j = 0; j < 8; ++j) { const int k = 4 * c.lane + 256 * j; *(f32x4*)(xrow + k) = v[j] * rstd * gg[j]; } }
}
constexpr int NPHASE = 19;
constexpr int SC_ONE = 0x7F7F7F7F, SC_W = 0x79797979  , SC_H = 0x7C7C7C7C  ;
#ifndef PROBE_MASK
#define PROBE_MASK 0u
#endif
#define REPS(k) (1 + (int)((PROBE_MASK >> (k)) & 1u))
__global__ void __launch_bounds__(NTHR, 2) mega(Params p) {
    extern __shared__ __attribute__((aligned(16))) unsigned char lds_[];
    Ctx c; c.lds = (LAS unsigned char*)lds_; c.tid = threadIdx.x; c.lane = c.tid & 63; c.wave = __builtin_amdgcn_readfirstlane(c.tid >> 6); c.bid = blockIdx.x; c.nb = gridDim.x;
    unsigned char* ws = p.ws;
    volatile LAS unsigned* MISC = (volatile LAS unsigned*)(c.lds + MISC_OFF);
    if (c.tid < 64) MISC[c.tid] = 0u;
    __syncthreads();
    XcdBarrier bar; bar.bar = (unsigned*)(ws + WS_CTL) + CW_BAR; bar.x = 0; bar.st = nullptr;
    if (p.hi - p.lo > 1) bar = xcd_barrier_post((unsigned*)(ws + WS_CTL) + CW_BAR, MISC + 8);
#ifndef PH_MASK
#define PH_MASK 0x7FFFFu
#endif
#define IN(k) (((PH_MASK >> (k)) & 1u) && p.lo <= (k) && (k) < p.hi)
#define SEAM(k) do { if (IN(k) && IN((k) + 1)) xcd_barrier(bar); } while (0)
    bf16* XN = (bf16*)(ws + WS_XN); bf16* MIX = (bf16*)(ws + WS_MIX);
    const int* TILEE = (const int*)(ws + WS_TILEE);

    if (IN(0)) for (int rep_ = 0; rep_ < REPS(0); ++rep_) { phase_convert(p, c); phase_rms_gates(p, c); } SEAM(0);
    if (IN(1)) for (int rep_ = 0; rep_ < REPS(1); ++rep_) {
        { pg8::Gemm g{XN, (const bf16*)(ws + WS_W0IN), M, 2048, D}; pg8::StaticOrder S; S.init(M, 2048, c.nb, c.bid); pg8::EpiL0In E{(bf16*)(ws + WS_GLU), (bf16*)(ws + WS_Z), 0};
          pg8::gemm_phase<pg8::EpiL0In, pg8::StaticOrder, true, true>(c.lds, g, S, E); }
        { pg8::Gemm g{MIX, (const bf16*)(ws + WS_W0IN + 12 * MiB), M, 4096, D / 2, SC_ONE, SC_W}; pg8::StaticOrder S; S.init(M, 4096, c.nb, c.bid); pg8::EpiPlain E{(bf16*)(ws + WS_Z), 4096};
          pg8::gemm_phase<pg8::EpiPlain, pg8::StaticOrder, true, true, true>(c.lds, g, S, E); } } SEAM(1);
    if (IN(2)) for (int rep_ = 0; rep_ < REPS(2); ++rep_) { phase_conv31(p, c); phase_ml_local(p, c); } SEAM(2);
    if (IN(3)) for (int rep_ = 0; rep_ < REPS(3); ++rep_) { phase_ml_scan(p, c); } SEAM(3);
    if (IN(4)) for (int rep_ = 0; rep_ < REPS(4); ++rep_) { phase_ml_out(p, c); } SEAM(4);
    if (IN(5)) for (int rep_ = 0; rep_ < REPS(5); ++rep_) { pg8::Gemm g{MIX, (const bf16*)(ws + WS_W0OUT), M, D, D}; pg8::StaticOrder S; S.init(M, D, c.nb, c.bid); pg8::EpiResid E{p.in[I_X], p.out, D};
        pg8::gemm_phase<pg8::EpiResid, pg8::StaticOrder, true, true>(c.lds, g, S, E); } SEAM(5);
    if (IN(6)) for (int rep_ = 0; rep_ < REPS(6); ++rep_) { phase_rms<false>(p.out, p.in[I_E_NORM_FFN], XN, c); } SEAM(6);
    if (IN(7)) for (int rep_ = 0; rep_ < REPS(7); ++rep_) { pg8::Gemm g{XN, (const bf16*)(ws + WS_W013), M, 2 * FF, D}; pg8::StaticOrder S; S.init(M, 2 * FF, c.nb, c.bid); pg8::EpiSwiglu8 E{(ws + WS_H), FF};
        pg8::gemm_phase<pg8::EpiSwiglu8, pg8::StaticOrder, true, true>(c.lds, g, S, E); } SEAM(7);
    if (IN(8)) for (int rep_ = 0; rep_ < REPS(8); ++rep_) { pg8::Gemm g{(const bf16*)(ws + WS_H), (const bf16*)(ws + WS_W02), M, D, FF / 2, SC_H, SC_W}; pg8::StaticOrder S; S.init(M, D, c.nb, c.bid); pg8::EpiResid E{p.out, p.out, D};
        pg8::gemm_phase<pg8::EpiResid, pg8::StaticOrder, true, true, true>(c.lds, g, S, E); } SEAM(8);
    if (IN(9)) for (int rep_ = 0; rep_ < REPS(9); ++rep_) { phase_rms<true>(p.out, p.in[I_O_NORM_MIX], XN, c); } SEAM(9);
    if (IN(10)) for (int rep_ = 0; rep_ < REPS(10); ++rep_) { pg8::Gemm g{XN, (const bf16*)(ws + WS_W1IN), M, 4096, D / 2, SC_ONE, SC_W}; pg8::StaticOrder S; S.init(M, 4096, c.nb, c.bid); pg8::EpiL1In E{(bf16*)(ws + WS_QKV), (bf16*)(ws + WS_U)};
        pg8::gemm_phase<pg8::EpiL1In, pg8::StaticOrder, true, true, true>(c.lds, g, S, E); } SEAM(10);
    if (IN(11)) for (int rep_ = 0; rep_ < REPS(11); ++rep_) { phase_attn(p, c); phase_s5(p, c); } SEAM(11);
    if (IN(12)) for (int rep_ = 0; rep_ < REPS(12); ++rep_) { pg8::Gemm g{(const bf16*)(ws + WS_Y), (const bf16*)(ws + WS_WGLU), M, 1024, 1024}; pg8::StaticOrder S; S.init(M, 1024, c.nb, c.bid);
        pg8::EpiGluGate E{(const bf16*)(ws + WS_Y), p.in[I_O_B_GLU], MIX, 2048, 1024};
        pg8::gemm_phase<pg8::EpiGluGate, pg8::StaticOrder, true, true>(c.lds, g, S, E); phase_attn_merge(p, c); } SEAM(12);
    if (IN(13)) for (int rep_ = 0; rep_ < REPS(13); ++rep_) { pg8::Gemm g{MIX, (const bf16*)(ws + WS_W1OUT), M, D, D}; pg8::StaticOrder S; S.init(M, D, c.nb, c.bid); pg8::EpiResid E{p.out, p.out, D};
        pg8::gemm_phase<pg8::EpiResid, pg8::StaticOrder, true, true>(c.lds, g, S, E); } SEAM(13);
    if (IN(14)) for (int rep_ = 0; rep_ < REPS(14); ++rep_) { phase_route(p, c); } SEAM(14);
    if (IN(15)) for (int rep_ = 0; rep_ < REPS(15); ++rep_) { phase_assign(p, c); } SEAM(15);
    if (IN(16)) for (int rep_ = 0; rep_ < REPS(16); ++rep_) { const int nt = TILEE[255]; pg8::Gemm g{(const bf16*)(ws + WS_XG), (const bf16*)(ws + WS_WE13), nt * 256, 2 * FF, D / 2, SC_ONE, SC_W};
        pg8::MoeOrder S; S.init(nt * 256, 2 * FF, c.nb, c.bid); S.tile_e = TILEE; S.estride = (size_t)2 * FF * D; pg8::EpiSwiglu8 E{(ws + WS_HG), FF};
        pg8::gemm_phase<pg8::EpiSwiglu8, pg8::MoeOrder, true, true, true>(c.lds, g, S, E); } SEAM(16);
    if (IN(17)) for (int rep_ = 0; rep_ < REPS(17); ++rep_) { const int nt = TILEE[255]; pg8::Gemm g{(const bf16*)(ws + WS_HG), (const bf16*)(ws + WS_WE2), nt * 256, D, FF / 2, SC_H, SC_W};
        pg8::MoeOrder S; S.init(nt * 256, D, c.nb, c.bid); S.tile_e = TILEE; S.estride = (size_t)D * FF; pg8::EpiPlain E{(bf16*)(ws + WS_XG), D};
        pg8::gemm_phase<pg8::EpiPlain, pg8::MoeOrder, true, true, true>(c.lds, g, S, E); } SEAM(17);
    if (IN(18)) for (int rep_ = 0; rep_ < REPS(18); ++rep_) { phase_final(p, c); }
#undef IN
#undef SEAM
}

extern "C" void kernel_launch(void* const* d_in, const int* in_sizes, int n_in, void* d_out, int out_size, void* d_ws, size_t ws_size, hipStream_t stream) {
    static int grid = 0;
    if (grid == 0) {
        if (n_in != N_IN || out_size != M * D || ws_size < WS_END) { fprintf(stderr, "kernel_launch: unexpected shapes (n_in %d out %d ws %zu need %zu)\n", n_in, out_size, ws_size, (size_t)WS_END); grid = -1; return; }
        int dev = 0, cus = 0;
        if (hipGetDevice(&dev) != hipSuccess || hipDeviceGetAttribute(&cus, hipDeviceAttributeMultiprocessorCount, dev) != hipSuccess) { grid = -1; return; }
        if (hipFuncSetAttribute((const void*)mega, hipFuncAttributeMaxDynamicSharedMemorySize, LDS_BYTES) != hipSuccess) { fprintf(stderr, "kernel_launch: hipFuncSetAttribute failed\n"); grid = -1; return; }
        int per_cu = 0; (void)hipOccupancyMaxActiveBlocksPerMultiprocessor(&per_cu, (const void*)mega, NTHR, LDS_BYTES); (void)hipGetLastError();
        if (per_cu < 1) fprintf(stderr, "kernel_launch: occupancy query reports %d blocks per CU\n", per_cu);
        grid = cus;
    }
    if (grid < 0) return;
    (void)hipMemsetAsync((char*)d_ws + WS_CTL, 0, CTL_BYTES, stream);
    Params p{};
    for (int i = 0; i < N_IN; ++i) p.in[i] = (const float*)d_in[i];
    p.out = (float*)d_out; p.ws = (unsigned char*)d_ws;
#ifndef MK_FUSED
#define MK_FUSED 1
#endif
    if (MK_FUSED) { p.lo = 0; p.hi = NPHASE; hipLaunchKernelGGL(mega, dim3(grid), dim3(NTHR), LDS_BYTES, stream, p); }
    else for (int k = 0; k < NPHASE; ++k) { p.lo = k; p.hi = k + 1; hipLaunchKernelGGL(mega, dim3(grid), dim3(NTHR), LDS_BYTES, stream, p); }
}
```
